# Optimizing an MI355X kernel written in HIP

```python
import jax, jax.numpy as jnp
from jax import lax
import numpy as np

D_MODEL = 1024
BATCH = 4
SEQ = 4096
DEPTH = 4

D_MIX = D_MODEL
D_POOL = D_MIX // 2
D_HGRN = D_MIX - D_POOL
POOL_WINDOWS = (2, 4, 8, 16)
N_POOL_GROUPS = len(POOL_WINDOWS)
POOL_GROUP_DIM = D_POOL // N_POOL_GROUPS
HGRN_HEADS = 4
HGRN_HEAD_DIM = D_HGRN // HGRN_HEADS
CHUNK = 64
D_IN = D_POOL + 4 * D_HGRN
D_FF = ((8 * D_MODEL // 3 + 127) // 128) * 128
ALPHA = (2.0 * DEPTH) ** 0.25
BETA = (8.0 * DEPTH) ** -0.25
LN_EPS = 1e-5
RMS_EPS = 1e-6

kernel_name = "macaron_pool_hgrn2_deepnorm_hybrid"


def layer_norm(x, g, b):
    x32 = x.astype(jnp.float32)
    mu = jnp.mean(x32, axis=-1, keepdims=True)
    var = jnp.mean(jnp.square(x32 - mu), axis=-1, keepdims=True)
    y = (x32 - mu) * lax.rsqrt(var + LN_EPS) * g.astype(jnp.float32) + b.astype(jnp.float32)
    return y.astype(x.dtype)


def swiglu(x, w_gate, w_up, w_down):
    return (jax.nn.silu(x @ w_gate) * (x @ w_up)) @ w_down


def multiscale_pool(u, pool_w, pool_scale):
    B, S, _ = u.shape
    u32 = u.astype(jnp.float32).reshape(B, S, N_POOL_GROUPS, POOL_GROUP_DIM)
    c = jnp.cumsum(u32, axis=1)
    pos = jnp.arange(S)
    means = []
    for g, w in enumerate(POOL_WINDOWS):
        cg = c[:, :, g]
        lag = jnp.pad(cg, ((0, 0), (w, 0), (0, 0)))[:, :S]
        cnt = jnp.minimum(pos + 1, w).astype(jnp.float32)[None, :, None]
        means.append((cg - lag) / cnt)
    pooled = jnp.stack(means, axis=2) - u32
    y = jnp.einsum('bsgc,gcd->bsgd', pooled.astype(u.dtype), pool_w)
    return y.reshape(B, S, D_POOL) * pool_scale


def hgrn2_recurrence(q, f_raw, v, lb):
    B, S, _ = q.shape
    n = S // CHUNK
    log_f = jnp.logaddexp(jnp.log(lb), jnp.log1p(-lb) + jax.nn.log_sigmoid(f_raw))
    k = (1.0 - lb) * jax.nn.sigmoid(-f_raw)
    q = q * (HGRN_HEAD_DIM ** -0.5)

    def heads(t):
        return t.reshape(B, n, CHUNK, HGRN_HEADS, HGRN_HEAD_DIM).transpose(1, 0, 3, 2, 4)

    causal = jnp.tril(jnp.ones((CHUNK, CHUNK), dtype=bool))[:, :, None]

    def step(state, inp):
        q_c, k_c, v_c, g_c = inp
        b = jnp.cumsum(g_c, axis=2)
        o_inter = jnp.einsum('bhtd,bhdv->bhtv', q_c * jnp.exp(b), state)
        rel = b[:, :, :, None, :] - b[:, :, None, :, :]
        decay = jnp.exp(jnp.where(causal, rel, -jnp.inf))
        scores = jnp.einsum('bhtd,bhsd,bhtsd->bhts', q_c, k_c, decay)
        o_intra = jnp.einsum('bhts,bhsv->bhtv', scores, v_c)
        b_last = b[:, :, -1:, :]
        k_dec = k_c * jnp.exp(b_last - b)
        new_state = jnp.exp(b_last[:, :, 0, :])[..., None] * state + jnp.einsum('bhsd,bhsv->bhdv', k_dec, v_c)
        return new_state, o_inter + o_intra

    s0 = jnp.zeros((B, HGRN_HEADS, HGRN_HEAD_DIM, HGRN_HEAD_DIM), jnp.float32)
    _, o = lax.scan(step, s0, (heads(q), heads(k), heads(v), heads(log_f)))
    return o.transpose(1, 0, 3, 2, 4).reshape(B, S, D_HGRN)


def head_rms_norm(o, g):
    B, S, _ = o.shape
    o = o.reshape(B, S, HGRN_HEADS, HGRN_HEAD_DIM)
    o = o * lax.rsqrt(jnp.mean(jnp.square(o), axis=-1, keepdims=True) + RMS_EPS) * g.astype(jnp.float32)
    return o.reshape(B, S, D_HGRN)


def setup_inputs(seed: int = 0) -> dict:
    key = jax.random.key(seed)
    ks = jax.random.split(key, 16)
    nrm = jax.random.normal
    f32 = jnp.float32
    x = nrm(ks[0], (BATCH, SEQ, D_MODEL), f32)
    w_in = nrm(ks[1], (DEPTH, D_MODEL, D_IN), f32) * D_MODEL ** -0.5
    pool_w = nrm(ks[2], (DEPTH, N_POOL_GROUPS, POOL_GROUP_DIM, POOL_GROUP_DIM), f32) * POOL_GROUP_DIM ** -0.5
    pool_scale = 1.0 + 0.02 * nrm(ks[3], (DEPTH, D_POOL), f32)
    lb_param = 0.5 * nrm(ks[4], (DEPTH, D_HGRN), f32)
    hgrn_norm_g = 1.0 + 0.02 * nrm(ks[5], (DEPTH, HGRN_HEAD_DIM), f32)
    w_out = nrm(ks[6], (DEPTH, D_MIX, D_MODEL), f32) * (D_MIX ** -0.5 * BETA)
    ffn1_gate = nrm(ks[7], (DEPTH, D_MODEL, D_FF), f32) * D_MODEL ** -0.5
    ffn1_up = nrm(ks[8], (DEPTH, D_MODEL, D_FF), f32) * D_MODEL ** -0.5
    ffn1_down = nrm(ks[9], (DEPTH, D_FF, D_MODEL), f32) * (D_FF ** -0.5 * BETA)
    ffn2_gate = nrm(ks[10], (DEPTH, D_MODEL, D_FF), f32) * D_MODEL ** -0.5
    ffn2_up = nrm(ks[11], (DEPTH, D_MODEL, D_FF), f32) * D_MODEL ** -0.5
    ffn2_down = nrm(ks[12], (DEPTH, D_FF, D_MODEL), f32) * (D_FF ** -0.5 * BETA)
    ln_g = 1.0 + 0.02 * nrm(ks[13], (DEPTH, 3, D_MODEL), f32)
    ln_b = 0.02 * nrm(ks[14], (DEPTH, 3, D_MODEL), f32)
    return {"x": x, "w_in": w_in, "pool_w": pool_w, "pool_scale": pool_scale, "lb_param": lb_param,
            "hgrn_norm_g": hgrn_norm_g, "w_out": w_out, "ffn1_gate": ffn1_gate, "ffn1_up": ffn1_up,
            "ffn1_down": ffn1_down, "ffn2_gate": ffn2_gate, "ffn2_up": ffn2_up, "ffn2_down": ffn2_down,
            "ln_g": ln_g, "ln_b": ln_b}


def reference(x, w_in, pool_w, pool_scale, lb_param, hgrn_norm_g, w_out, ffn1_gate, ffn1_up, ffn1_down,
              ffn2_gate, ffn2_up, ffn2_down, ln_g, ln_b):
    f32 = jnp.float32
    lb_all = jnp.cumsum(jax.nn.softmax(lb_param.astype(f32), axis=0), axis=0)
    lb_all = lb_all - lb_all[0:1]
    for l in range(DEPTH):
        x = layer_norm(ALPHA * x + 0.5 * swiglu(x, ffn1_gate[l], ffn1_up[l], ffn1_down[l]), ln_g[l, 0], ln_b[l, 0])
        h = x @ w_in[l]
        u = h[..., :D_POOL]
        q, f_raw, v, g = jnp.split(h[..., D_POOL:], 4, axis=-1)
        y_pool = multiscale_pool(u, pool_w[l], pool_scale[l])
        o = hgrn2_recurrence(q.astype(f32), f_raw.astype(f32), v.astype(f32), lb_all[l])
        y_hgrn = head_rms_norm(o, hgrn_norm_g[l]) * jax.nn.silu(g.astype(f32))
        mix = jnp.concatenate([y_pool.astype(x.dtype), y_hgrn.astype(x.dtype)], axis=-1) @ w_out[l]
        x = layer_norm(ALPHA * x + mix, ln_g[l, 1], ln_b[l, 1])
        x = layer_norm(ALPHA * x + 0.5 * swiglu(x, ffn2_gate[l], ffn2_up[l], ffn2_down[l]), ln_g[l, 2], ln_b[l, 2])
    return x
```

```cpp
#include <hip/hip_runtime.h>
#include <hip/hip_cooperative_groups.h>
#include <cstdio>
#include <cstdint>
namespace cg = cooperative_groups;
namespace pg8 {
#define PG8_LAS __attribute__((address_space(3)))
typedef unsigned short bf16_t;
typedef short bf16x8 __attribute__((ext_vector_type(8)));
typedef float f32x4 __attribute__((ext_vector_type(4)));
typedef unsigned u32x4 __attribute__((ext_vector_type(4)));
constexpr int BM = 256, BK = 64, HALF = 128, HTB = HALF * BK * 2  , STAGE_BYTES = 8 * HTB, NXCD = 8, WGM = 8;

__host__ __device__ __forceinline__ int lds_byte(int r, int c) { const int st = (r >> 4) * 2 + (c >> 5), rr = r & 15, cc = c & 31, ob = rr * 64 + cc * 2; return st * 1024 + (ob ^ (((ob >> 9) & 1) << 5)); }
__host__ __device__ __forceinline__ void stage_rc(int b, int& R, int& C) { const int st = b / 1024, sb = b % 1024, swz = sb ^ (((sb >> 9) & 1) << 5); R = (st >> 1) * 16 + swz / 64; C = (st & 1) * 32 + (swz % 64) / 2; }
__host__ __device__ __forceinline__ int perm32(int rho) { const int n = rho >> 4, i = rho & 15; return 8 * (i >> 2) + 4 * n + (i & 3); }

struct Unit { int pm, pn; };
struct Gemm { const bf16_t* A; const bf16_t* Bt; int M, N, K; };

struct StaticOrder {
    int nM, nN, nwg, G, c;
    __host__ __device__ void init(int M, int N, int G_, int c_) { nM = M / BM; nN = N / BM; nwg = nM * nN; G = G_; c = c_; }
    __host__ __device__ bool next(int i, Unit& u) const {
        const long L = (long)i * G + c; if (L >= nwg) return false;
        int wgid = (int)L; { const int q = nwg / NXCD, r = nwg % NXCD, xcd = wgid % NXCD, off = wgid / NXCD; wgid = (xcd < r ? xcd * (q + 1) : r * (q + 1) + (xcd - r) * q) + off; }
        const int nig = WGM * nN, gid = wgid / nig, fm = gid * WGM, gsz = (nM - fm) < WGM ? (nM - fm) : WGM;
        u.pm = fm + ((wgid % nig) % gsz); u.pn = (wgid % nig) / gsz; return true;
    }
    __device__ __forceinline__ void a_ready(const Unit&) const {}
    __device__ __forceinline__ void done(const Unit&) const {}
};

__device__ __forceinline__ unsigned cvt_pk_bf16(float lo, float hi) { unsigned r; asm volatile("v_cvt_pk_bf16_f32 %0, %1, %2" : "=v"(r) : "v"(lo), "v"(hi)); return r; }
__device__ __forceinline__ float silu_f(float x) { return x * __builtin_amdgcn_rcpf(1.0f + __builtin_amdgcn_exp2f(-1.4426950408889634f * x)); }
struct EpiSwiglu {
    static constexpr bool PERM = true, AFTER_DRAIN = false;
    bf16_t* H; int ldh;
    __device__ __forceinline__ void operator()(const f32x4 (&acc)[2][2][4][2], const Unit& u, int wr, int wc, int fr, int fq) const {
        const int row0 = u.pm * BM + wr * 64 + fr, col0 = u.pn * HALF + wc * 32 + 8 * fq;
#pragma unroll
        for (int ai = 0; ai < 2; ++ai)
#pragma unroll
            for (int m = 0; m < 4; ++m) { bf16_t* rowp = H + (size_t)(row0 + ai * HALF + m * 16) * ldh + col0;
                float h[8];
#pragma unroll
                for (int n = 0; n < 2; ++n)
#pragma unroll
                    for (int j = 0; j < 4; ++j) h[4 * n + j] = silu_f(acc[ai][0][m][n][j]) * acc[ai][1][m][n][j];
                u32x4 w; w.x = cvt_pk_bf16(h[0], h[1]); w.y = cvt_pk_bf16(h[2], h[3]); w.z = cvt_pk_bf16(h[4], h[5]); w.w = cvt_pk_bf16(h[6], h[7]);
                *(u32x4*)rowp = w; }
    }
};
struct EpiResid {
    static constexpr bool PERM = true, AFTER_DRAIN = false;
    const float* base; float* Z; int ldc; float alpha, sc;
    __device__ __forceinline__ void operator()(const f32x4 (&acc)[2][2][4][2], const Unit& u, int wr, int wc, int fr, int fq) const {
        const int row0 = u.pm * BM + wr * 64 + fr, col0 = u.pn * BM + wc * 32 + 8 * fq;
#pragma unroll
        for (int ai = 0; ai < 2; ++ai)
#pragma unroll
            for (int m = 0; m < 4; ++m) { const size_t off = (size_t)(row0 + ai * HALF + m * 16) * ldc + col0;
#pragma unroll
                for (int bj = 0; bj < 2; ++bj)
#pragma unroll
                    for (int n = 0; n < 2; ++n) { const f32x4 bs = *(const f32x4*)(base + off + bj * HALF + 4 * n);
                        *(f32x4*)(Z + off + bj * HALF + 4 * n) = bs * alpha + acc[ai][bj][m][n] * sc; }
                asm volatile("" ::: "memory"); }
    }
};
struct EpiIn {
    static constexpr bool PERM = true, AFTER_DRAIN = false;
    bf16_t *U, *Q, *V, *SG; float* LOGF; const float* lb;
    __device__ __forceinline__ void operator()(const f32x4 (&acc)[2][2][4][2], const Unit& u, int wr, int wc, int fr, int fq) const {
        const int typ = u.pn >> 1;
        const int row0 = u.pm * BM + wr * 64 + fr, col0 = (u.pn & 1) * BM + wc * 32 + 8 * fq;
        if (typ == 2) {
            float lbv[2][8];
#pragma unroll
            for (int bj = 0; bj < 2; ++bj)
#pragma unroll
                for (int j = 0; j < 8; ++j) lbv[bj][j] = lb[col0 + bj * HALF + j];
#pragma unroll
            for (int ai = 0; ai < 2; ++ai)
#pragma unroll
                for (int m = 0; m < 4; ++m) { float* rowp = LOGF + (size_t)(row0 + ai * HALF + m * 16) * 512 + col0;
#pragma unroll
                    for (int bj = 0; bj < 2; ++bj)
#pragma unroll
                        for (int n = 0; n < 2; ++n) { f32x4 o;
#pragma unroll
                            for (int j = 0; j < 4; ++j) { const float x = acc[ai][bj][m][n][j], l = lbv[bj][4 * n + j];
                                const float sig = __builtin_amdgcn_rcpf(1.0f + __builtin_amdgcn_exp2f(-1.4426950408889634f * x));
                                o[j] = 0.6931471805599453f * __builtin_amdgcn_logf(fmaxf(l + (1.0f - l) * sig, 1e-37f)); }
                            *(f32x4*)(rowp + bj * HALF + 4 * n) = o; } }
        } else {
            bf16_t* O = typ == 0 ? U : (typ == 1 ? Q : (typ == 3 ? V : SG));
            const float sc = typ == 1 ? 0.08838834764831845f : 1.0f;
#pragma unroll
            for (int ai = 0; ai < 2; ++ai)
#pragma unroll
                for (int m = 0; m < 4; ++m) { bf16_t* rowp = O + (size_t)(row0 + ai * HALF + m * 16) * 512 + col0;
#pragma unroll
                    for (int bj = 0; bj < 2; ++bj) { f32x4 v0 = acc[ai][bj][m][0] * sc, v1 = acc[ai][bj][m][1] * sc;
                        if (typ == 4) {
#pragma unroll
                            for (int j = 0; j < 4; ++j) { v0[j] = silu_f(v0[j]); v1[j] = silu_f(v1[j]); } }
                        u32x4 w; w.x = cvt_pk_bf16(v0[0], v0[1]); w.y = cvt_pk_bf16(v0[2], v0[3]); w.z = cvt_pk_bf16(v1[0], v1[1]); w.w = cvt_pk_bf16(v1[2], v1[3]);
                        *(u32x4*)(rowp + bj * HALF) = w; } }
        }
    }
};
template <class Epi, class Sched, bool ALIGN_EPI = false, bool SP2 = false>
__device__ __forceinline__ void gemm_phase(PG8_LAS unsigned char* lds, const Gemm g, const Sched& S, const Epi& E) {
    int tid_ = threadIdx.x; asm volatile("" : "+v"(tid_));
    const int tid = tid_, wid = __builtin_amdgcn_readfirstlane(tid >> 6), lane = tid & 63, wr = wid >> 2, wc = wid & 3, fr = lane & 15, fq = lane >> 4;
    const int K = g.K, nt = K / BK;
    unsigned voffA[2], voffB[2];
#pragma unroll
    for (int i = 0; i < 2; ++i) { int R, C; stage_rc(tid * 16 + i * 8192, R, C); const int Rb = Epi::PERM ? ((R & ~31) + perm32(R & 31)) : R;
        voffA[i] = (unsigned)(R * K + C) * 2u; voffB[i] = (unsigned)(Rb * K + C) * 2u; }
    const size_t kstep = (size_t)(BK * 2);
    const size_t hstep = (size_t)HALF * K * 2;
    const size_t tstep = 2 * hstep;
    const unsigned ldsw = (unsigned)wid * 1024u;
    const int aoff = lds_byte(wr * 64 + fr, fq * 8), boff = lds_byte(wc * 32 + fr, fq * 8);
#define PG8_SA(b, h) (((b) * 2 + (h)) * HTB)
#define PG8_SB(b, h) ((4 + (b) * 2 + (h)) * HTB)
#define PG8_STAGE(bufoff, gbase, voff) do { _Pragma("unroll") for (int _i = 0; _i < 2; ++_i) \
        __builtin_amdgcn_global_load_lds((const unsigned*)((const char*)(gbase) + (voff)[_i]), (PG8_LAS unsigned*)(lds + (bufoff) + ldsw + _i * 8192), 16, 0, 0); } while (0)
#define PG8_LDA(dst, b, h) do { _Pragma("unroll") for (int m = 0; m < 4; ++m) _Pragma("unroll") for (int k = 0; k < 2; ++k) dst[m][k] = *(const PG8_LAS bf16x8*)(lds + PG8_SA(b, h) + aoff + m * 2048 + k * 1024); } while (0)
#define PG8_LDB(dst, b, h) do { _Pragma("unroll") for (int n = 0; n < 2; ++n) _Pragma("unroll") for (int k = 0; k < 2; ++k) dst[n][k] = *(const PG8_LAS bf16x8*)(lds + PG8_SB(b, h) + boff + n * 2048 + k * 1024); } while (0)
#define PG8_MMA(ai, bj, At, Bt) do { __builtin_amdgcn_s_setprio(1); _Pragma("unroll") for (int m = 0; m < 4; ++m) _Pragma("unroll") for (int n = 0; n < 2; ++n) _Pragma("unroll") for (int k = 0; k < 2; ++k) \
        acc[ai][bj][m][n] = __builtin_amdgcn_mfma_f32_16x16x32_bf16(Bt[n][k], At[m][k], acc[ai][bj][m][n], 0, 0, 0); __builtin_amdgcn_s_setprio(0); } while (0)
#define PG8_WAIT_V(n) asm volatile("s_waitcnt vmcnt(" #n ")" ::: "memory")
#define PG8_WAIT_L(n) asm volatile("s_waitcnt lgkmcnt(" #n ")" ::: "memory")
#define PG8_BAR __builtin_amdgcn_s_barrier()
#define PG8_SCHED __builtin_amdgcn_sched_barrier(0)
    Unit cur, nxt; int ui = 0;
    if (!S.next(0, cur)) return;
    f32x4 acc[2][2][4][2];
#pragma unroll
    for (int a = 0; a < 2; ++a)
#pragma unroll
        for (int b = 0; b < 2; ++b)
#pragma unroll
            for (int m = 0; m < 4; ++m)
#pragma unroll
                for (int n = 0; n < 2; ++n) acc[a][b][m][n] = (f32x4){0.f, 0.f, 0.f, 0.f};
    bf16x8 At[4][2], B0[2][2], B1[2][2];
    const char* cA = (const char*)g.A + (size_t)cur.pm * tstep; const char* cB = (const char*)g.Bt + (size_t)cur.pn * tstep;
    S.a_ready(cur);
    if constexpr (SP2) {
        PG8_STAGE(PG8_SB(0, 0), cB, voffB); PG8_STAGE(PG8_SB(0, 1), cB + hstep, voffB); PG8_STAGE(PG8_SA(0, 0), cA, voffA); PG8_STAGE(PG8_SA(0, 1), cA + hstep, voffA);
        if (wr == 1) PG8_BAR;
        PG8_WAIT_V(2); PG8_BAR;
        PG8_STAGE(PG8_SB(1, 0), cB + kstep, voffB); PG8_STAGE(PG8_SA(1, 0), cA + kstep, voffA); PG8_STAGE(PG8_SB(1, 1), cB + hstep + kstep, voffB);
        PG8_WAIT_V(6); PG8_BAR;
    } else {
        PG8_STAGE(PG8_SB(0, 0), cB, voffB); PG8_STAGE(PG8_SA(0, 0), cA, voffA); PG8_STAGE(PG8_SB(0, 1), cB + hstep, voffB); PG8_STAGE(PG8_SA(0, 1), cA + hstep, voffA);
        if (wr == 1) PG8_BAR;
        PG8_WAIT_V(4); PG8_BAR;
        PG8_STAGE(PG8_SB(1, 0), cB + kstep, voffB); PG8_STAGE(PG8_SA(1, 0), cA + kstep, voffA); PG8_STAGE(PG8_SB(1, 1), cB + hstep + kstep, voffB);
        PG8_WAIT_V(6); PG8_BAR;
    }
    for (;;) {
        const bool has_next = S.next(ui + 1, nxt);
        const char* nA = has_next ? (const char*)g.A + (size_t)nxt.pm * tstep : cA; const char* nB = has_next ? (const char*)g.Bt + (size_t)nxt.pn * tstep : cB;
        for (int t = 0; t < nt; t += 2) {
            const bool last = (t == nt - 2);
            const char* a1 = cA + (size_t)(t + 1) * kstep;
            const char* a2 = last ? nA : cA + (size_t)(t + 2) * kstep; const char* b2 = last ? nB : cB + (size_t)(t + 2) * kstep;
            const char* a3 = a2 + kstep; const char* b3 = b2 + kstep;
            if (last && has_next) S.a_ready(nxt);
            if constexpr (SP2) {
            PG8_LDB(B0, 0, 0); PG8_LDB(B1, 0, 1); PG8_SCHED; PG8_LDA(At, 0, 0); PG8_STAGE(PG8_SA(1, 1), a1 + hstep, voffA);
            PG8_WAIT_V(8); PG8_WAIT_L(0); PG8_BAR; PG8_MMA(0, 0, At, B0); PG8_MMA(0, 1, At, B1); PG8_BAR; PG8_SCHED;
            PG8_LDA(At, 0, 1); PG8_STAGE(PG8_SB(0, 0), b2, voffB); PG8_STAGE(PG8_SB(0, 1), b2 + hstep, voffB); PG8_STAGE(PG8_SA(0, 0), a2, voffA);
            PG8_WAIT_V(8); PG8_WAIT_L(0); PG8_BAR; PG8_MMA(1, 0, At, B0); PG8_MMA(1, 1, At, B1); PG8_BAR; PG8_SCHED;
            PG8_LDB(B0, 1, 0); PG8_LDB(B1, 1, 1); PG8_SCHED; PG8_LDA(At, 1, 0); PG8_STAGE(PG8_SA(0, 1), a2 + hstep, voffA);
            PG8_WAIT_V(8); PG8_WAIT_L(0); PG8_BAR; PG8_MMA(0, 0, At, B0); PG8_MMA(0, 1, At, B1); PG8_BAR; PG8_SCHED;
            PG8_LDA(At, 1, 1); PG8_STAGE(PG8_SB(1, 0), b3, voffB); PG8_STAGE(PG8_SB(1, 1), b3 + hstep, voffB); PG8_STAGE(PG8_SA(1, 0), a3, voffA);
            PG8_WAIT_V(8); PG8_WAIT_L(0); PG8_BAR; PG8_MMA(1, 0, At, B0); PG8_MMA(1, 1, At, B1); PG8_BAR; PG8_SCHED;
            } else {
            PG8_LDB(B0, 0, 0); PG8_SCHED; PG8_LDA(At, 0, 0); PG8_STAGE(PG8_SA(1, 1), a1 + hstep, voffA);
            PG8_WAIT_L(8); PG8_BAR; PG8_WAIT_L(0); PG8_MMA(0, 0, At, B0); PG8_BAR; PG8_SCHED;
            PG8_LDB(B1, 0, 1); PG8_STAGE(PG8_SB(0, 0), b2, voffB);
            PG8_BAR; PG8_WAIT_L(0); PG8_MMA(0, 1, At, B1); PG8_BAR;
            PG8_LDA(At, 0, 1); PG8_STAGE(PG8_SA(0, 0), a2, voffA);
            PG8_BAR; PG8_WAIT_L(0); PG8_MMA(1, 0, At, B0); PG8_BAR; PG8_SCHED;
            PG8_STAGE(PG8_SB(0, 1), b2 + hstep, voffB);
            PG8_WAIT_V(6); PG8_BAR; PG8_MMA(1, 1, At, B1); PG8_BAR;
            PG8_LDB(B0, 1, 0); PG8_SCHED; PG8_LDA(At, 1, 0); PG8_STAGE(PG8_SA(0, 1), a2 + hstep, voffA);
            PG8_WAIT_L(8); PG8_BAR; PG8_WAIT_L(0); PG8_MMA(0, 0, At, B0); PG8_BAR; PG8_SCHED;
            PG8_LDB(B1, 1, 1); PG8_STAGE(PG8_SB(1, 0), b3, voffB);
            PG8_BAR; PG8_WAIT_L(0); PG8_MMA(0, 1, At, B1); PG8_BAR;
            PG8_LDA(At, 1, 1); PG8_STAGE(PG8_SA(1, 0), a3, voffA);
            PG8_BAR; PG8_WAIT_L(0); PG8_MMA(1, 0, At, B0); PG8_BAR; PG8_SCHED;
            PG8_STAGE(PG8_SB(1, 1), b3 + hstep, voffB);
            PG8_WAIT_V(6); PG8_BAR; PG8_MMA(1, 1, At, B1); PG8_BAR;
            }
        }
        if constexpr (ALIGN_EPI) { if (wr == 0) PG8_BAR; }
        if constexpr (!Epi::AFTER_DRAIN) { E(acc, cur, wr, wc, fr, fq); S.done(cur); }
        if (!has_next) break;
#pragma unroll
        for (int a = 0; a < 2; ++a)
#pragma unroll
            for (int b = 0; b < 2; ++b)
#pragma unroll
                for (int m = 0; m < 4; ++m)
#pragma unroll
                    for (int n = 0; n < 2; ++n) acc[a][b][m][n] = (f32x4){0.f, 0.f, 0.f, 0.f};
        cur = nxt; cA = nA; cB = nB; ++ui;
        if constexpr (ALIGN_EPI) { if (wr == 1) PG8_BAR; }
    }
    PG8_WAIT_V(0);
    if constexpr (!ALIGN_EPI) { if (wr == 0) PG8_BAR; }
    PG8_BAR;
    if constexpr (Epi::AFTER_DRAIN) { E.fused(acc, cur, wr, wc, fr, fq, lds, wid, lane); S.done(cur); }
#undef PG8_SA
#undef PG8_SB
#undef PG8_STAGE
#undef PG8_LDA
#undef PG8_LDB
#undef PG8_MMA
#undef PG8_WAIT_V
#undef PG8_WAIT_L
#undef PG8_BAR
#undef PG8_SCHED
}
}
#define LAS __attribute__((address_space(3)))
typedef unsigned short bf16;
typedef float f32x4 __attribute__((ext_vector_type(4)));
typedef unsigned v4u __attribute__((ext_vector_type(4)));
typedef unsigned v2u __attribute__((ext_vector_type(2)));
typedef short bf16x8 __attribute__((ext_vector_type(8)));
constexpr int NB = 4, SEQ = 4096, M = NB * SEQ, D = 1024, DEPTH = 4, DFF = 2816, DP = 512, DH = 512, NHEAD = 4, HD = 128, DIN = 2560, CHUNK = 64;
constexpr float ALPHA = 1.6817928305074290f;
constexpr float LN_EPS = 1e-5f, RMS_EPS = 1e-6f;
constexpr int NWAVES = 8, NTHR = 512;
constexpr int LDS_BYTES = 147456;
constexpr size_t WS_CTL = 0, CTL_BYTES = 131072;
constexpr size_t CT_LB = 0, CT_PSC = 8192, CT_GN = 16384, CT_LNG = 32768, CT_LNB = 81920;
constexpr size_t SZ_WGU = (size_t)2 * DFF * D * 2, SZ_WD = (size_t)D * DFF * 2, SZ_WIN = (size_t)DIN * D * 2, SZ_WOUT = (size_t)D * D * 2, SZ_WPOOL = (size_t)4 * 128 * 128 * 2;
constexpr size_t WO_GU1 = 0, WO_D1 = WO_GU1 + SZ_WGU, WO_IN = WO_D1 + SZ_WD, WO_OUT = WO_IN + SZ_WIN, WO_GU2 = WO_OUT + SZ_WOUT, WO_D2 = WO_GU2 + SZ_WGU, WO_POOL = WO_D2 + SZ_WD, WL_STRIDE = WO_POOL + SZ_WPOOL;
constexpr size_t WS_W = WS_CTL + CTL_BYTES;
constexpr size_t WS_XB = WS_W + DEPTH * WL_STRIDE;
constexpr size_t WS_R1 = WS_XB + (size_t)M * D * 2;
constexpr size_t R1_BYTES = (size_t)96 << 20;
constexpr size_t WS_R2 = WS_R1 + R1_BYTES;
constexpr size_t WS_YMIX = WS_R2 + (size_t)M * D * 4;
constexpr size_t WS_END = WS_YMIX + (size_t)M * D * 2;
static_assert((size_t)M * DFF * 2 <= R1_BYTES, "H fits R1");

__device__ __forceinline__ unsigned f2bf(float f) { unsigned u = __builtin_bit_cast(unsigned, f); return (u + 0x7fffu + ((u >> 16) & 1u)) >> 16; }
__device__ __forceinline__ unsigned pk2(float lo, float hi) { return f2bf(lo) | (f2bf(hi) << 16); }
__device__ __forceinline__ float bf2f(unsigned short b) { return __builtin_bit_cast(float, (unsigned)b << 16); }
__device__ __forceinline__ float wave_sum(float v) {
#pragma unroll
    for (int o = 1; o < 64; o <<= 1) v += __shfl_xor(v, o);
    return v;
}
#define LDS_WAIT() asm volatile("s_waitcnt lgkmcnt(0)" ::: "memory")

__device__ __forceinline__ void transpose_item(const float* W, int K, int N, bf16* WT, int dst_row0, LAS float* scr, int k0, int n0, int lane) {
#pragma unroll 8
    for (int i = 0; i < 32; ++i) { const int kk = 2 * i + (lane >> 5); scr[kk * 33 + (lane & 31)] = W[(size_t)(k0 + kk) * N + n0 + (lane & 31)]; }
    LDS_WAIT(); asm volatile("" ::: "memory");
    const int c = lane & 7;
#pragma unroll
    for (int j = 0; j < 4; ++j) { const int n = (lane >> 3) + 8 * j; const LAS float* s = scr + (8 * c) * 33 + n;
        v4u o; o.x = pk2(s[0 * 33], s[1 * 33]); o.y = pk2(s[2 * 33], s[3 * 33]); o.z = pk2(s[4 * 33], s[5 * 33]); o.w = pk2(s[6 * 33], s[7 * 33]);
        *(v4u*)(WT + (size_t)(dst_row0 + n) * K + k0 + 8 * c) = o; }
    LDS_WAIT(); asm volatile("" ::: "memory");
}

struct Args { const float* in[15]; float* out; unsigned char* ws; };

__device__ __forceinline__ void p0_prologue(const Args& a, LAS unsigned char* lds, int G) {
    int tid_ = threadIdx.x; asm volatile("" : "+v"(tid_));
    const int tid = tid_, lane = tid & 63, wave = tid >> 6;
    LAS float* scr = (LAS float*)(lds + wave * 16384);
    const int gw = blockIdx.x * NWAVES + wave, NGW = G * NWAVES;
    constexpr int I_GU = (D / 64) * (DFF / 32), I_DN = (DFF / 64) * (D / 32), I_IN = (D / 64) * (DIN / 32), I_OUT = (D / 64) * (D / 32), I_PL = 4 * 2 * 4;
    constexpr int PER_L = 4 * I_GU + 2 * I_DN + I_IN + I_OUT + I_PL;
    for (int it = gw; it < DEPTH * PER_L; it += NGW) {
        const int l = it / PER_L; int r = it - l * PER_L;
        unsigned char* wl = a.ws + WS_W + (size_t)l * WL_STRIDE;
        if (r < 4 * I_GU) { const int which = r / I_GU; r -= which * I_GU; const int nblk = DFF / 32, kb = r / nblk, nb = r % nblk, n0 = 32 * nb;
            const float* W = a.in[which == 0 ? 7 : (which == 1 ? 8 : (which == 2 ? 10 : 11))] + (size_t)l * D * DFF;
            bf16* WT = (bf16*)(wl + (which < 2 ? WO_GU1 : WO_GU2));
            const int dst = 256 * (n0 >> 7) + (n0 & 127) + ((which & 1) ? 128 : 0);
            transpose_item(W, D, DFF, WT, dst, scr, 64 * kb, n0, lane); continue; }
        r -= 4 * I_GU;
        if (r < 2 * I_DN) { const int which = r / I_DN; r -= which * I_DN; const int nblk = D / 32, kb = r / nblk, nb = r % nblk;
            const float* W = a.in[which == 0 ? 9 : 12] + (size_t)l * DFF * D;
            transpose_item(W, DFF, D, (bf16*)(wl + (which == 0 ? WO_D1 : WO_D2)), 32 * nb, scr, 64 * kb, 32 * nb, lane); continue; }
        r -= 2 * I_DN;
        if (r < I_IN) { const int nblk = DIN / 32, kb = r / nblk, nb = r % nblk;
            transpose_item(a.in[1] + (size_t)l * D * DIN, D, DIN, (bf16*)(wl + WO_IN), 32 * nb, scr, 64 * kb, 32 * nb, lane); continue; }
        r -= I_IN;
        if (r < I_OUT) { const int nblk = D / 32, kb = r / nblk, nb = r % nblk;
            transpose_item(a.in[6] + (size_t)l * D * D, D, D, (bf16*)(wl + WO_OUT), 32 * nb, scr, 64 * kb, 32 * nb, lane); continue; }
        r -= I_OUT;
        { const int g = r >> 3, q = r & 7, kb = q >> 2, nb = q & 3;
            transpose_item(a.in[2] + ((size_t)l * 4 + g) * 128 * 128, 128, 128, (bf16*)(wl + WO_POOL) + (size_t)g * 128 * 128, 32 * nb, scr, 64 * kb, 32 * nb, lane); }
    }
    { const f32x4* x4 = (const f32x4*)a.in[0]; v4u* o = (v4u*)(a.ws + WS_XB);
      for (size_t i = (size_t)blockIdx.x * NTHR + tid; i < (size_t)M * D / 8; i += (size_t)G * NTHR) { const f32x4 p = x4[2 * i], q = x4[2 * i + 1];
          v4u w; w.x = pk2(p[0], p[1]); w.y = pk2(p[2], p[3]); w.z = pk2(q[0], q[1]); w.w = pk2(q[2], q[3]); o[i] = w;
          ((f32x4*)a.out)[2 * i] = p; ((f32x4*)a.out)[2 * i + 1] = q; } }
    if (blockIdx.x == 1) { float* c = (float*)(a.ws + WS_CTL);
        for (int i = tid; i < 4 * 512; i += NTHR) c[CT_PSC / 4 + i] = a.in[3][i];
        for (int i = tid; i < 4 * 128; i += NTHR) c[CT_GN / 4 + i] = a.in[5][i];
        for (int i = tid; i < 12 * 1024; i += NTHR) { c[CT_LNG / 4 + i] = a.in[13][i]; c[CT_LNB / 4 + i] = a.in[14][i]; } }
    if (blockIdx.x == 0) { const int c = tid; const float* lp = a.in[4]; float* LB = (float*)(a.ws + WS_CTL);
        const float p0 = lp[c], p1 = lp[512 + c], p2 = lp[1024 + c], p3 = lp[1536 + c];
        const float mx = fmaxf(fmaxf(p0, p1), fmaxf(p2, p3));
        const float e0 = expf(p0 - mx), e1 = expf(p1 - mx), e2 = expf(p2 - mx), e3 = expf(p3 - mx), inv = 1.0f / (e0 + e1 + e2 + e3);
        LB[c] = 0.f; LB[512 + c] = e1 * inv; LB[1024 + c] = (e1 + e2) * inv; LB[1536 + c] = (e1 + e2 + e3) * inv; }
}

__device__ __forceinline__ void ln_phase(const float* Z, const float* g, const float* b, float* X, bf16* XB, int G) {
    int tid_ = threadIdx.x; asm volatile("" : "+v"(tid_));
    const int tid = tid_, lane = tid & 63, wave = tid >> 6;
    const int gw = blockIdx.x * NWAVES + wave, NGW = G * NWAVES;
    f32x4 gv[4], bv[4];
#pragma unroll
    for (int j = 0; j < 4; ++j) { gv[j] = ((const f32x4*)g)[lane + 64 * j]; bv[j] = ((const f32x4*)b)[lane + 64 * j]; }
    for (int m = gw; m < M; m += NGW) {
        const f32x4* zr = (const f32x4*)(Z + (size_t)m * D) + lane;
        f32x4 v[4]; float s = 0.f;
#pragma unroll
        for (int j = 0; j < 4; ++j) { v[j] = zr[64 * j]; s += (v[j][0] + v[j][1]) + (v[j][2] + v[j][3]); }
        const float mean = wave_sum(s) * (1.f / D); float s2 = 0.f;
#pragma unroll
        for (int j = 0; j < 4; ++j) { v[j] = v[j] - mean; s2 += (v[j][0] * v[j][0] + v[j][1] * v[j][1]) + (v[j][2] * v[j][2] + v[j][3] * v[j][3]); }
        const float rstd = 1.0f / sqrtf(wave_sum(s2) * (1.f / D) + LN_EPS);
        f32x4* xo = (f32x4*)(X + (size_t)m * D) + lane; v2u* bo = (v2u*)(XB + (size_t)m * D) + lane;
#pragma unroll
        for (int j = 0; j < 4; ++j) { const f32x4 y = v[j] * rstd * gv[j] + bv[j]; xo[64 * j] = y; v2u w; w.x = pk2(y[0], y[1]); w.y = pk2(y[2], y[3]); bo[64 * j] = w; }
    }
}

__device__ __forceinline__ void pool_phase(const bf16* U, const bf16* WP  , const float* pscale  , bf16* YMIX, LAS unsigned char* lds, int G) {
    int tid_ = threadIdx.x; asm volatile("" : "+v"(tid_));
    const int tid = tid_, lane = tid & 63, wave = tid >> 6, fr = lane & 15, fq = lane >> 4;
    LAS bf16* Us = (LAS bf16*)lds;
    LAS bf16* As = (LAS bf16*)(lds + 36864);
    LAS bf16* Bs = (LAS bf16*)(lds + 36864 + 34816);
    for (int un = blockIdx.x; un < 512; un += G) {
        const int tile = un >> 2, g = un & 3, m0 = tile * 128, pos0 = m0 & (SEQ - 1), w = 2 << g;
        for (int i = tid; i < 144 * 16; i += NTHR) { const int r = i >> 4, c16 = i & 15; v4u val = {0u, 0u, 0u, 0u};
            if (!(pos0 == 0 && r < 16)) val = *(const v4u*)(U + (size_t)(m0 - 16 + r) * 512 + g * 128 + c16 * 8);
            *(LAS v4u*)(Us + r * 128 + c16 * 8) = val; }
        for (int i = tid; i < 128 * 16; i += NTHR) { const int r = i >> 4, c16 = i & 15;
            *(LAS v4u*)(Bs + r * 136 + c16 * 8) = *(const v4u*)(WP + (size_t)g * 128 * 128 + r * 128 + c16 * 8); }
        __syncthreads();
        { const int c = tid & 127, r0 = (tid >> 7) * 32; float s = 0.f;
          for (int j = 1; j < w; ++j) s += bf2f(Us[(16 + r0 - j) * 128 + c]);
          for (int r = r0; r < r0 + 32; ++r) { const float cur = bf2f(Us[(16 + r) * 128 + c]); s += cur;
              const int pos = pos0 + r; const float cnt = (float)(pos + 1 < w ? pos + 1 : w);
              As[r * 136 + c] = (bf16)f2bf(s / cnt - cur);
              s -= bf2f(Us[(16 + r - (w - 1)) * 128 + c]); } }
        __syncthreads();
        { bf16x8 af[4]; f32x4 acc[8];
#pragma unroll
          for (int k = 0; k < 4; ++k) af[k] = *(const LAS bf16x8*)(As + (16 * wave + fr) * 136 + k * 32 + fq * 8);
#pragma unroll
          for (int nt = 0; nt < 8; ++nt) { acc[nt] = (f32x4){0.f, 0.f, 0.f, 0.f};
#pragma unroll
              for (int k = 0; k < 4; ++k) { const bf16x8 bfr = *(const LAS bf16x8*)(Bs + (nt * 16 + fr) * 136 + k * 32 + fq * 8);
                  acc[nt] = __builtin_amdgcn_mfma_f32_16x16x32_bf16(bfr, af[k], acc[nt], 0, 0, 0); } }
          const int row = m0 + 16 * wave + fr;
#pragma unroll
          for (int nt = 0; nt < 8; ++nt) { const int d = nt * 16 + fq * 4; const f32x4 ps = *(const f32x4*)(pscale + g * 128 + d); const f32x4 y = acc[nt] * ps;
              v2u o; o.x = pk2(y[0], y[1]); o.y = pk2(y[2], y[3]); *(v2u*)(YMIX + (size_t)row * D + g * 128 + d) = o; } }
        __syncthreads();
    }
}

__device__ __forceinline__ void hgrn_seq_phase(const bf16* Q, const bf16* V, const float* LOGF, float* O, LAS unsigned char* lds, int G) {
    int tid_ = threadIdx.x; asm volatile("" : "+v"(tid_));
    const int tid = tid_, lane = tid & 63, wave = tid >> 6;
    LAS float* Fs = (LAS float*)lds; LAS float* Qs = (LAS float*)(lds + 32768); LAS float* Vs = (LAS float*)(lds + 65536); LAS float* Os = (LAS float*)(lds + 65536 + 2048);
    for (int un = blockIdx.x; un < 256; un += G) {
        const int b = un >> 6, h = (un >> 4) & 3, vs = un & 15;
        float S0 = 0.f, S1 = 0.f;
        for (int ch = 0; ch < SEQ / CHUNK; ++ch) { const int m0 = b * SEQ + ch * CHUNK;
            for (int i = tid; i < 64 * 128; i += NTHR) { const int t = i >> 7, d = i & 127; const size_t gi = (size_t)(m0 + t) * 512 + h * 128 + d;
                Fs[i] = __expf(LOGF[gi]); Qs[i] = bf2f(Q[gi]); }
            { const int t = tid >> 3, j = tid & 7; Vs[tid] = bf2f(V[(size_t)(m0 + t) * 512 + h * 128 + vs * 8 + j]); }
            __syncthreads();
#pragma unroll 4
            for (int t = 0; t < 64; ++t) { const float f0 = Fs[t * 128 + lane], f1 = Fs[t * 128 + 64 + lane], q0 = Qs[t * 128 + lane], q1 = Qs[t * 128 + 64 + lane], vt = Vs[t * 8 + wave];
                S0 = f0 * S0 + (1.0f - f0) * vt; S1 = f1 * S1 + (1.0f - f1) * vt;
                const float p = wave_sum(S0 * q0 + S1 * q1);
                if (lane == 0) Os[t * 8 + wave] = p; }
            __syncthreads();
            { const int t = tid >> 3, j = tid & 7; O[(size_t)(m0 + t) * 512 + h * 128 + vs * 8 + j] = Os[tid]; }
        }
        __syncthreads();
    }
}
__device__ __forceinline__ void hgrn_norm_phase(const float* O, const float* gn  , const bf16* SG, bf16* YMIX, int G) {
    int tid_ = threadIdx.x; asm volatile("" : "+v"(tid_));
    const int tid = tid_, lane = tid & 63, wave = tid >> 6;
    const int gw = blockIdx.x * NWAVES + wave, NGW = G * NWAVES;
    const f32x4 g0 = *(const f32x4*)(gn + ((8 * lane) & 127)), g1 = *(const f32x4*)(gn + ((8 * lane) & 127) + 4);
    for (int m = gw; m < M; m += NGW) {
        const f32x4 o0 = *(const f32x4*)(O + (size_t)m * 512 + 8 * lane), o1 = *(const f32x4*)(O + (size_t)m * 512 + 8 * lane + 4);
        float ss = (o0[0] * o0[0] + o0[1] * o0[1]) + (o0[2] * o0[2] + o0[3] * o0[3]) + (o1[0] * o1[0] + o1[1] * o1[1]) + (o1[2] * o1[2] + o1[3] * o1[3]);
        ss += __shfl_xor(ss, 1); ss += __shfl_xor(ss, 2); ss += __shfl_xor(ss, 4); ss += __shfl_xor(ss, 8);
        const float rstd = 1.0f / sqrtf(ss * (1.0f / 128.0f) + RMS_EPS);
        const v4u sg = *(const v4u*)(SG + (size_t)m * 512 + 8 * lane);
        float y[8];
#pragma unroll
        for (int j = 0; j < 4; ++j) { y[j] = o0[j] * rstd * g0[j]; y[4 + j] = o1[j] * rstd * g1[j]; }
        y[0] *= bf2f((unsigned short)(sg.x & 0xffff)); y[1] *= bf2f((unsigned short)(sg.x >> 16)); y[2] *= bf2f((unsigned short)(sg.y & 0xffff)); y[3] *= bf2f((unsigned short)(sg.y >> 16));
        y[4] *= bf2f((unsigned short)(sg.z & 0xffff)); y[5] *= bf2f((unsigned short)(sg.z >> 16)); y[6] *= bf2f((unsigned short)(sg.w & 0xffff)); y[7] *= bf2f((unsigned short)(sg.w >> 16));
        v4u w; w.x = pk2(y[0], y[1]); w.y = pk2(y[2], y[3]); w.z = pk2(y[4], y[5]); w.w = pk2(y[6], y[7]);
        *(v4u*)(YMIX + (size_t)m * D + 512 + 8 * lane) = w;
    }
}

__global__ void __launch_bounds__(NTHR, 2) trunk_fwd(Args a) {
    extern __shared__ __attribute__((aligned(16))) unsigned char lds_raw[];
    LAS unsigned char* lds = (LAS unsigned char*)lds_raw;
    cg::grid_group grid = cg::this_grid();
    const int G = gridDim.x;
    p0_prologue(a, lds, G);
    grid.sync();
#define PTRS() unsigned wl_ = __builtin_amdgcn_readfirstlane((unsigned)(size_t)a.ws), wh_ = __builtin_amdgcn_readfirstlane((unsigned)((size_t)a.ws >> 32)), \
             xl_ = __builtin_amdgcn_readfirstlane((unsigned)(size_t)a.out), xh_ = __builtin_amdgcn_readfirstlane((unsigned)((size_t)a.out >> 32)); \
    asm volatile("" : "+s"(wl_), "+s"(wh_), "+s"(xl_), "+s"(xh_)); \
    unsigned char* ws = (unsigned char*)(((size_t)wh_ << 32) | wl_); float* X = (float*)(((size_t)xh_ << 32) | xl_); \
    bf16* XB = (bf16*)(ws + WS_XB); bf16* H = (bf16*)(ws + WS_R1); \
    bf16* U = (bf16*)(ws + WS_R1); bf16* Q = U + (size_t)M * 512; bf16* V = Q + (size_t)M * 512; bf16* SG = V + (size_t)M * 512; float* LOGF = (float*)(SG + (size_t)M * 512); \
    float* Z = (float*)(ws + WS_R2); float* O = (float*)(ws + WS_R2); bf16* YMIX = (bf16*)(ws + WS_YMIX); \
    const float* CT = (const float*)(ws + WS_CTL); const unsigned char* wl = ws + WS_W + (size_t)l * WL_STRIDE; \
    (void)XB; (void)H; (void)U; (void)Q; (void)V; (void)SG; (void)LOGF; (void)Z; (void)O; (void)YMIX; (void)CT; (void)wl; (void)X
#pragma nounroll
    for (int l = 0; l < DEPTH; ++l) {
#pragma nounroll
        for (int half = 0; half < 2; ++half) {
            if (half == 1) {
#ifndef SKIP_IN
                { PTRS(); pg8::Gemm g{XB, (const bf16*)(wl + WO_IN), M, DIN, D}; pg8::StaticOrder S; S.init(M, DIN, G, (int)blockIdx.x);
                  pg8::EpiIn E{U, Q, V, SG, LOGF, CT + CT_LB / 4 + l * 512};
                  pg8::gemm_phase<pg8::EpiIn, pg8::StaticOrder, true, true>(lds, g, S, E); }
#endif
                grid.sync();
#ifndef SKIP_POOL
                { PTRS(); pool_phase(U, (const bf16*)(wl + WO_POOL), CT + CT_PSC / 4 + l * 512, YMIX, lds, G); }
#endif
#ifndef SKIP_SEQ
                { PTRS(); hgrn_seq_phase(Q, V, LOGF, O, lds, G); }
#endif
                grid.sync();
                { PTRS(); hgrn_norm_phase(O, CT + CT_GN / 4 + l * 128, SG, YMIX, G); }
                grid.sync();
#ifndef SKIP_OUT
                { PTRS(); pg8::Gemm g{YMIX, (const bf16*)(wl + WO_OUT), M, D, D}; pg8::StaticOrder S; S.init(M, D, G, (int)blockIdx.x);
                  pg8::EpiResid E{X, Z, D, ALPHA, 1.0f};
                  pg8::gemm_phase<pg8::EpiResid, pg8::StaticOrder, true, true>(lds, g, S, E); }
#endif
                grid.sync();
                { PTRS(); ln_phase(Z, CT + CT_LNG / 4 + (l * 3 + 1) * D, CT + CT_LNB / 4 + (l * 3 + 1) * D, X, XB, G); }
                grid.sync();
            }
#ifndef SKIP_GU
            { PTRS(); pg8::Gemm g{XB, (const bf16*)(wl + (half == 0 ? WO_GU1 : WO_GU2)), M, 2 * DFF, D}; pg8::StaticOrder S; S.init(M, 2 * DFF, G, (int)blockIdx.x);
              pg8::EpiSwiglu E{H, DFF};
              pg8::gemm_phase<pg8::EpiSwiglu, pg8::StaticOrder, true, true>(lds, g, S, E); }
#endif
            grid.sync();
#ifndef SKIP_DN
            { PTRS(); pg8::Gemm g{H, (const bf16*)(wl + (half == 0 ? WO_D1 : WO_D2)), M, D, DFF}; pg8::StaticOrder S; S.init(M, D, G, (int)blockIdx.x);
              pg8::EpiResid E{X, Z, D, ALPHA, 0.5f};
              pg8::gemm_phase<pg8::EpiResid, pg8::StaticOrder, true, true>(lds, g, S, E); }
#endif
            grid.sync();
            { PTRS(); const int li = l * 3 + (half == 0 ? 0 : 2); ln_phase(Z, CT + CT_LNG / 4 + li * D, CT + CT_LNB / 4 + li * D, X, XB, G); }
            grid.sync();
        }
    }
}

extern "C" void kernel_launch(void* const* d_in, const int* in_sizes, int n_in, void* d_out, int out_size, void* d_ws, size_t ws_size, hipStream_t stream) {
    static int grid = 0;
    if (grid == 0) {
        if (n_in != 15 || in_sizes[0] != M * D || out_size != M * D || ws_size < WS_END) { fprintf(stderr, "kernel_launch: shape/workspace mismatch (n_in %d, in0 %d, out %d, ws %zu, need %zu)\n", n_in, n_in > 0 ? in_sizes[0] : -1, out_size, ws_size, (size_t)WS_END); grid = -1; return; }
        int dev = 0, cus = 0, per_cu = 0;
        hipGetDevice(&dev); hipDeviceGetAttribute(&cus, hipDeviceAttributeMultiprocessorCount, dev);
        if (hipFuncSetAttribute((const void*)trunk_fwd, hipFuncAttributeMaxDynamicSharedMemorySize, LDS_BYTES) != hipSuccess) { fprintf(stderr, "kernel_launch: hipFuncSetAttribute failed\n"); grid = -1; return; }
        if (hipOccupancyMaxActiveBlocksPerMultiprocessor(&per_cu, (const void*)trunk_fwd, NTHR, LDS_BYTES) != hipSuccess || per_cu < 1) { fprintf(stderr, "kernel_launch: occupancy query says %d\n", per_cu); per_cu = 1; }
        (void)hipGetLastError();
        grid = cus * 1;
    }
    if (grid < 0) return;
    Args a{};
    for (int i = 0; i < 15; ++i) a.in[i] = (const float*)d_in[i];
    a.out = (float*)d_out; a.ws = (unsigned char*)d_ws;
    void* kargs[] = {&a};
    hipError_t e = hipLaunchCooperativeKernel((const void*)trunk_fwd, dim3(grid), dim3(NTHR), kargs, LDS_BYTES, stream);
    if (e != hipSuccess) fprintf(stderr, "kernel_launch: cooperative launch failed: %s (grid %d)\n", hipGetErrorString(e), grid);
}
```

```cpp
#include <hip/hip_runtime.h>
#include <hip/hip_cooperative_groups.h>
#include <cstdio>
#include <cstdint>
namespace cg = cooperative_groups;
namespace pg8 {
#define PG8_LAS __attribute__((address_space(3)))
typedef unsigned short bf16_t;
typedef short bf16x8 __attribute__((ext_vector_type(8)));
typedef float f32x4 __attribute__((ext_vector_type(4)));
typedef unsigned u32x4 __attribute__((ext_vector_type(4)));
constexpr int BM = 256, BK = 64, HALF = 128, HTB = HALF * BK * 2  , STAGE_BYTES = 8 * HTB, NXCD = 8, WGM = 8;

__host__ __device__ __forceinline__ int lds_byte(int r, int c) { const int st = (r >> 4) * 2 + (c >> 5), rr = r & 15, cc = c & 31, ob = rr * 64 + cc * 2; return st * 1024 + (ob ^ (((ob >> 9) & 1) << 5)); }
__host__ __device__ __forceinline__ void stage_rc(int b, int& R, int& C) { const int st = b / 1024, sb = b % 1024, swz = sb ^ (((sb >> 9) & 1) << 5); R = (st >> 1) * 16 + swz / 64; C = (st & 1) * 32 + (swz % 64) / 2; }
__host__ __device__ __forceinline__ int perm32(int rho) { const int n = rho >> 4, i = rho & 15; return 8 * (i >> 2) + 4 * n + (i & 3); }

struct Unit { int pm, pn; };
struct Gemm { const bf16_t* A; const bf16_t* Bt; int M, N, K; };

struct StaticOrder {
    int nM, nN, nwg, G, c;
    __host__ __device__ void init(int M, int N, int G_, int c_) { nM = M / BM; nN = N / BM; nwg = nM * nN; G = G_; c = c_; }
    __host__ __device__ bool next(int i, Unit& u) const {
        const long L = (long)i * G + c; if (L >= nwg) return false;
        int wgid = (int)L; { const int q = nwg / NXCD, r = nwg % NXCD, xcd = wgid % NXCD, off = wgid / NXCD; wgid = (xcd < r ? xcd * (q + 1) : r * (q + 1) + (xcd - r) * q) + off; }
        const int nig = WGM * nN, gid = wgid / nig, fm = gid * WGM, gsz = (nM - fm) < WGM ? (nM - fm) : WGM;
        u.pm = fm + ((wgid % nig) % gsz); u.pn = (wgid % nig) / gsz; return true;
    }
    __device__ __forceinline__ void a_ready(const Unit&) const {}
    __device__ __forceinline__ void done(const Unit&) const {}
};

__device__ __forceinline__ unsigned cvt_pk_bf16(float lo, float hi) { unsigned r; asm volatile("v_cvt_pk_bf16_f32 %0, %1, %2" : "=v"(r) : "v"(lo), "v"(hi)); return r; }
__device__ __forceinline__ float silu_f(float x) { return x * __builtin_amdgcn_rcpf(1.0f + __builtin_amdgcn_exp2f(-1.4426950408889634f * x)); }
struct EpiSwiglu {
    static constexpr bool PERM = true, AFTER_DRAIN = false;
    bf16_t* H; int ldh;
    __device__ __forceinline__ void operator()(const f32x4 (&acc)[2][2][4][2], const Unit& u, int wr, int wc, int fr, int fq) const {
        const int row0 = u.pm * BM + wr * 64 + fr, col0 = u.pn * HALF + wc * 32 + 8 * fq;
#pragma unroll
        for (int ai = 0; ai < 2; ++ai)
#pragma unroll
            for (int m = 0; m < 4; ++m) { bf16_t* rowp = H + (size_t)(row0 + ai * HALF + m * 16) * ldh + col0;
                float h[8];
#pragma unroll
                for (int n = 0; n < 2; ++n)
#pragma unroll
                    for (int j = 0; j < 4; ++j) h[4 * n + j] = silu_f(acc[ai][0][m][n][j]) * acc[ai][1][m][n][j];
                u32x4 w; w.x = cvt_pk_bf16(h[0], h[1]); w.y = cvt_pk_bf16(h[2], h[3]); w.z = cvt_pk_bf16(h[4], h[5]); w.w = cvt_pk_bf16(h[6], h[7]);
                *(u32x4*)rowp = w; }
    }
};
struct EpiResid {
    static constexpr bool PERM = true, AFTER_DRAIN = false;
    const float* base; float* Z; int ldc; float alpha, sc;
    __device__ __forceinline__ void operator()(const f32x4 (&acc)[2][2][4][2], const Unit& u, int wr, int wc, int fr, int fq) const {
        const int row0 = u.pm * BM + wr * 64 + fr, col0 = u.pn * BM + wc * 32 + 8 * fq;
#pragma unroll
        for (int ai = 0; ai < 2; ++ai)
#pragma unroll
            for (int m = 0; m < 4; ++m) { const size_t off = (size_t)(row0 + ai * HALF + m * 16) * ldc + col0;
#pragma unroll
                for (int bj = 0; bj < 2; ++bj)
#pragma unroll
                    for (int n = 0; n < 2; ++n) { const f32x4 bs = *(const f32x4*)(base + off + bj * HALF + 4 * n);
                        *(f32x4*)(Z + off + bj * HALF + 4 * n) = bs * alpha + acc[ai][bj][m][n] * sc; }
                asm volatile("" ::: "memory"); }
    }
};
struct EpiIn {
    static constexpr bool PERM = true, AFTER_DRAIN = false;
    bf16_t *U, *Q, *V, *SG; float* LOGF; const float* lb;
    __device__ __forceinline__ void operator()(const f32x4 (&acc)[2][2][4][2], const Unit& u, int wr, int wc, int fr, int fq) const {
        const int typ = u.pn >> 1;
        const int row0 = u.pm * BM + wr * 64 + fr, col0 = (u.pn & 1) * BM + wc * 32 + 8 * fq;
        if (typ == 2) {
            float lbv[2][8];
#pragma unroll
            for (int bj = 0; bj < 2; ++bj)
#pragma unroll
                for (int j = 0; j < 8; ++j) lbv[bj][j] = lb[col0 + bj * HALF + j];
#pragma unroll
            for (int ai = 0; ai < 2; ++ai)
#pragma unroll
                for (int m = 0; m < 4; ++m) { float* rowp = LOGF + (size_t)(row0 + ai * HALF + m * 16) * 512 + col0;
#pragma unroll
                    for (int bj = 0; bj < 2; ++bj)
#pragma unroll
                        for (int n = 0; n < 2; ++n) { f32x4 o;
#pragma unroll
                            for (int j = 0; j < 4; ++j) { const float x = acc[ai][bj][m][n][j], l = lbv[bj][4 * n + j];
                                const float sig = __builtin_amdgcn_rcpf(1.0f + __builtin_amdgcn_exp2f(-1.4426950408889634f * x));
                                o[j] = 0.6931471805599453f * __builtin_amdgcn_logf(fmaxf(l + (1.0f - l) * sig, 1e-37f)); }
                            *(f32x4*)(rowp + bj * HALF + 4 * n) = o; } }
        } else {
            bf16_t* O = typ == 0 ? U : (typ == 1 ? Q : (typ == 3 ? V : SG));
            const float sc = typ == 1 ? 0.08838834764831845f : 1.0f;
#pragma unroll
            for (int ai = 0; ai < 2; ++ai)
#pragma unroll
                for (int m = 0; m < 4; ++m) { bf16_t* rowp = O + (size_t)(row0 + ai * HALF + m * 16) * 512 + col0;
#pragma unroll
                    for (int bj = 0; bj < 2; ++bj) { f32x4 v0 = acc[ai][bj][m][0] * sc, v1 = acc[ai][bj][m][1] * sc;
                        if (typ == 4) {
#pragma unroll
                            for (int j = 0; j < 4; ++j) { v0[j] = silu_f(v0[j]); v1[j] = silu_f(v1[j]); } }
                        u32x4 w; w.x = cvt_pk_bf16(v0[0], v0[1]); w.y = cvt_pk_bf16(v0[2], v0[3]); w.z = cvt_pk_bf16(v1[0], v1[1]); w.w = cvt_pk_bf16(v1[2], v1[3]);
                        *(u32x4*)(rowp + bj * HALF) = w; } }
        }
    }
};
template <class Epi, class Sched, bool ALIGN_EPI = false, bool SP2 = false>
__device__ __forceinline__ void gemm_phase(PG8_LAS unsigned char* lds, const Gemm g, const Sched& S, const Epi& E) {
    int tid_ = threadIdx.x; asm volatile("" : "+v"(tid_));
    const int tid = tid_, wid = __builtin_amdgcn_readfirstlane(tid >> 6), lane = tid & 63, wr = wid >> 2, wc = wid & 3, fr = lane & 15, fq = lane >> 4;
    const int K = g.K, nt = K / BK;
    unsigned voffA[2], voffB[2];
#pragma unroll
    for (int i = 0; i < 2; ++i) { int R, C; stage_rc(tid * 16 + i * 8192, R, C); const int Rb = Epi::PERM ? ((R & ~31) + perm32(R & 31)) : R;
        voffA[i] = (unsigned)(R * K + C) * 2u; voffB[i] = (unsigned)(Rb * K + C) * 2u; }
    const size_t kstep = (size_t)(BK * 2);
    const size_t hstep = (size_t)HALF * K * 2;
    const size_t tstep = 2 * hstep;
    const unsigned ldsw = (unsigned)wid * 1024u;
    const int aoff = lds_byte(wr * 64 + fr, fq * 8), boff = lds_byte(wc * 32 + fr, fq * 8);
#define PG8_SA(b, h) (((b) * 2 + (h)) * HTB)
#define PG8_SB(b, h) ((4 + (b) * 2 + (h)) * HTB)
#define PG8_STAGE(bufoff, gbase, voff) do { _Pragma("unroll") for (int _i = 0; _i < 2; ++_i) \
        __builtin_amdgcn_global_load_lds((const unsigned*)((const char*)(gbase) + (voff)[_i]), (PG8_LAS unsigned*)(lds + (bufoff) + ldsw + _i * 8192), 16, 0, 0); } while (0)
#define PG8_LDA(dst, b, h) do { _Pragma("unroll") for (int m = 0; m < 4; ++m) _Pragma("unroll") for (int k = 0; k < 2; ++k) dst[m][k] = *(const PG8_LAS bf16x8*)(lds + PG8_SA(b, h) + aoff + m * 2048 + k * 1024); } while (0)
#define PG8_LDB(dst, b, h) do { _Pragma("unroll") for (int n = 0; n < 2; ++n) _Pragma("unroll") for (int k = 0; k < 2; ++k) dst[n][k] = *(const PG8_LAS bf16x8*)(lds + PG8_SB(b, h) + boff + n * 2048 + k * 1024); } while (0)
#define PG8_MMA(ai, bj, At, Bt) do { __builtin_amdgcn_s_setprio(1); _Pragma("unroll") for (int m = 0; m < 4; ++m) _Pragma("unroll") for (int n = 0; n < 2; ++n) _Pragma("unroll") for (int k = 0; k < 2; ++k) \
        acc[ai][bj][m][n] = __builtin_amdgcn_mfma_f32_16x16x32_bf16(Bt[n][k], At[m][k], acc[ai][bj][m][n], 0, 0, 0); __builtin_amdgcn_s_setprio(0); } while (0)
#define PG8_WAIT_V(n) asm volatile("s_waitcnt vmcnt(" #n ")" ::: "memory")
#define PG8_WAIT_L(n) asm volatile("s_waitcnt lgkmcnt(" #n ")" ::: "memory")
#define PG8_BAR __builtin_amdgcn_s_barrier()
#define PG8_SCHED __builtin_amdgcn_sched_barrier(0)
    Unit cur, nxt; int ui = 0;
    if (!S.next(0, cur)) return;
    f32x4 acc[2][2][4][2];
#pragma unroll
    for (int a = 0; a < 2; ++a)
#pragma unroll
        for (int b = 0; b < 2; ++b)
#pragma unroll
            for (int m = 0; m < 4; ++m)
#pragma unroll
                for (int n = 0; n < 2; ++n) acc[a][b][m][n] = (f32x4){0.f, 0.f, 0.f, 0.f};
    bf16x8 At[4][2], B0[2][2], B1[2][2];
    const char* cA = (const char*)g.A + (size_t)cur.pm * tstep; const char* cB = (const char*)g.Bt + (size_t)cur.pn * tstep;
    S.a_ready(cur);
    if constexpr (SP2) {
        PG8_STAGE(PG8_SB(0, 0), cB, voffB); PG8_STAGE(PG8_SB(0, 1), cB + hstep, voffB); PG8_STAGE(PG8_SA(0, 0), cA, voffA); PG8_STAGE(PG8_SA(0, 1), cA + hstep, voffA);
        if (wr == 1) PG8_BAR;
        PG8_WAIT_V(2); PG8_BAR;
        PG8_STAGE(PG8_SB(1, 0), cB + kstep, voffB); PG8_STAGE(PG8_SA(1, 0), cA + kstep, voffA); PG8_STAGE(PG8_SB(1, 1), cB + hstep + kstep, voffB);
        PG8_WAIT_V(6); PG8_BAR;
    } else {
        PG8_STAGE(PG8_SB(0, 0), cB, voffB); PG8_STAGE(PG8_SA(0, 0), cA, voffA); PG8_STAGE(PG8_SB(0, 1), cB + hstep, voffB); PG8_STAGE(PG8_SA(0, 1), cA + hstep, voffA);
        if (wr == 1) PG8_BAR;
        PG8_WAIT_V(4); PG8_BAR;
        PG8_STAGE(PG8_SB(1, 0), cB + kstep, voffB); PG8_STAGE(PG8_SA(1, 0), cA + kstep, voffA); PG8_STAGE(PG8_SB(1, 1), cB + hstep + kstep, voffB);
        PG8_WAIT_V(6); PG8_BAR;
    }
    for (;;) {
        const bool has_next = S.next(ui + 1, nxt);
        const char* nA = has_next ? (const char*)g.A + (size_t)nxt.pm * tstep : cA; const char* nB = has_next ? (const char*)g.Bt + (size_t)nxt.pn * tstep : cB;
        for (int t = 0; t < nt; t += 2) {
            const bool last = (t == nt - 2);
            const char* a1 = cA + (size_t)(t + 1) * kstep;
            const char* a2 = last ? nA : cA + (size_t)(t + 2) * kstep; const char* b2 = last ? nB : cB + (size_t)(t + 2) * kstep;
            const char* a3 = a2 + kstep; const char* b3 = b2 + kstep;
            if (last && has_next) S.a_ready(nxt);
            if constexpr (SP2) {
            PG8_LDB(B0, 0, 0); PG8_LDB(B1, 0, 1); PG8_SCHED; PG8_LDA(At, 0, 0); PG8_STAGE(PG8_SA(1, 1), a1 + hstep, voffA);
            PG8_WAIT_V(8); PG8_WAIT_L(0); PG8_BAR; PG8_MMA(0, 0, At, B0); PG8_MMA(0, 1, At, B1); PG8_BAR; PG8_SCHED;
            PG8_LDA(At, 0, 1); PG8_STAGE(PG8_SB(0, 0), b2, voffB); PG8_STAGE(PG8_SB(0, 1), b2 + hstep, voffB); PG8_STAGE(PG8_SA(0, 0), a2, voffA);
            PG8_WAIT_V(8); PG8_WAIT_L(0); PG8_BAR; PG8_MMA(1, 0, At, B0); PG8_MMA(1, 1, At, B1); PG8_BAR; PG8_SCHED;
            PG8_LDB(B0, 1, 0); PG8_LDB(B1, 1, 1); PG8_SCHED; PG8_LDA(At, 1, 0); PG8_STAGE(PG8_SA(0, 1), a2 + hstep, voffA);
            PG8_WAIT_V(8); PG8_WAIT_L(0); PG8_BAR; PG8_MMA(0, 0, At, B0); PG8_MMA(0, 1, At, B1); PG8_BAR; PG8_SCHED;
            PG8_LDA(At, 1, 1); PG8_STAGE(PG8_SB(1, 0), b3, voffB); PG8_STAGE(PG8_SB(1, 1), b3 + hstep, voffB); PG8_STAGE(PG8_SA(1, 0), a3, voffA);
            PG8_WAIT_V(8); PG8_WAIT_L(0); PG8_BAR; PG8_MMA(1, 0, At, B0); PG8_MMA(1, 1, At, B1); PG8_BAR; PG8_SCHED;
            } else {
            PG8_LDB(B0, 0, 0); PG8_SCHED; PG8_LDA(At, 0, 0); PG8_STAGE(PG8_SA(1, 1), a1 + hstep, voffA);
            PG8_WAIT_L(8); PG8_BAR; PG8_WAIT_L(0); PG8_MMA(0, 0, At, B0); PG8_BAR; PG8_SCHED;
            PG8_LDB(B1, 0, 1); PG8_STAGE(PG8_SB(0, 0), b2, voffB);
            PG8_BAR; PG8_WAIT_L(0); PG8_MMA(0, 1, At, B1); PG8_BAR;
            PG8_LDA(At, 0, 1); PG8_STAGE(PG8_SA(0, 0), a2, voffA);
            PG8_BAR; PG8_WAIT_L(0); PG8_MMA(1, 0, At, B0); PG8_BAR; PG8_SCHED;
            PG8_STAGE(PG8_SB(0, 1), b2 + hstep, voffB);
            PG8_WAIT_V(6); PG8_BAR; PG8_MMA(1, 1, At, B1); PG8_BAR;
            PG8_LDB(B0, 1, 0); PG8_SCHED; PG8_LDA(At, 1, 0); PG8_STAGE(PG8_SA(0, 1), a2 + hstep, voffA);
            PG8_WAIT_L(8); PG8_BAR; PG8_WAIT_L(0); PG8_MMA(0, 0, At, B0); PG8_BAR; PG8_SCHED;
            PG8_LDB(B1, 1, 1); PG8_STAGE(PG8_SB(1, 0), b3, voffB);
            PG8_BAR; PG8_WAIT_L(0); PG8_MMA(0, 1, At, B1); PG8_BAR;
            PG8_LDA(At, 1, 1); PG8_STAGE(PG8_SA(1, 0), a3, voffA);
            PG8_BAR; PG8_WAIT_L(0); PG8_MMA(1, 0, At, B0); PG8_BAR; PG8_SCHED;
            PG8_STAGE(PG8_SB(1, 1), b3 + hstep, voffB);
            PG8_WAIT_V(6); PG8_BAR; PG8_MMA(1, 1, At, B1); PG8_BAR;
            }
        }
        if constexpr (ALIGN_EPI) { if (wr == 0) PG8_BAR; }
        if constexpr (!Epi::AFTER_DRAIN) { E(acc, cur, wr, wc, fr, fq); S.done(cur); }
        if (!has_next) break;
#pragma unroll
        for (int a = 0; a < 2; ++a)
#pragma unroll
            for (int b = 0; b < 2; ++b)
#pragma unroll
                for (int m = 0; m < 4; ++m)
#pragma unroll
                    for (int n = 0; n < 2; ++n) acc[a][b][m][n] = (f32x4){0.f, 0.f, 0.f, 0.f};
        cur = nxt; cA = nA; cB = nB; ++ui;
        if constexpr (ALIGN_EPI) { if (wr == 1) PG8_BAR; }
    }
    PG8_WAIT_V(0);
    if constexpr (!ALIGN_EPI) { if (wr == 0) PG8_BAR; }
    PG8_BAR;
    if constexpr (Epi::AFTER_DRAIN) { E.fused(acc, cur, wr, wc, fr, fq, lds, wid, lane); S.done(cur); }
#undef PG8_SA
#undef PG8_SB
#undef PG8_STAGE
#undef PG8_LDA
#undef PG8_LDB
#undef PG8_MMA
#undef PG8_WAIT_V
#undef PG8_WAIT_L
#undef PG8_BAR
#undef PG8_SCHED
}
}
#define LAS __attribute__((address_space(3)))
typedef unsigned short bf16;
typedef float f32x4 __attribute__((ext_vector_type(4)));
typedef unsigned v4u __attribute__((ext_vector_type(4)));
typedef unsigned v2u __attribute__((ext_vector_type(2)));
typedef short bf16x8 __attribute__((ext_vector_type(8)));
constexpr int NB = 4, SEQ = 4096, M = NB * SEQ, D = 1024, DEPTH = 4, DFF = 2816, DP = 512, DH = 512, NHEAD = 4, HD = 128, DIN = 2560, CHUNK = 64;
constexpr float ALPHA = 1.6817928305074290f;
constexpr float LN_EPS = 1e-5f, RMS_EPS = 1e-6f;
constexpr int NWAVES = 8, NTHR = 512;
constexpr int LDS_BYTES = 147456;
constexpr size_t WS_CTL = 0, CTL_BYTES = 20480;
constexpr size_t CT_LB = 0, CT_PSC = 8192, CT_GN = 16384;
constexpr size_t SZ_WGU = (size_t)2 * DFF * D * 2, SZ_WD = (size_t)D * DFF * 2, SZ_WIN = (size_t)DIN * D * 2, SZ_WOUT = (size_t)D * D * 2, SZ_WPOOL = (size_t)4 * 128 * 128 * 2;
constexpr size_t WO_GU1 = 0, WO_D1 = WO_GU1 + SZ_WGU, WO_IN = WO_D1 + SZ_WD, WO_OUT = WO_IN + SZ_WIN, WO_GU2 = WO_OUT + SZ_WOUT, WO_D2 = WO_GU2 + SZ_WGU, WO_POOL = WO_D2 + SZ_WD, WL_STRIDE = WO_POOL + SZ_WPOOL;
constexpr size_t WS_W = WS_CTL + CTL_BYTES;
constexpr size_t WS_XB = WS_W + DEPTH * WL_STRIDE;
constexpr size_t WS_R1 = WS_XB + (size_t)M * D * 2;
constexpr size_t R1_BYTES = (size_t)96 << 20;
constexpr size_t WS_R2 = WS_R1 + R1_BYTES;
constexpr size_t WS_YMIX = WS_R2 + (size_t)M * D * 4;
constexpr size_t WS_DEC = WS_YMIX + (size_t)M * D * 2;
constexpr size_t WS_END = WS_DEC + (size_t)1024 * 128 * 4;
static_assert((size_t)M * DFF * 2 <= R1_BYTES, "H fits R1");

__device__ __forceinline__ unsigned f2bf(float f) { unsigned u = __builtin_bit_cast(unsigned, f); return (u + 0x7fffu + ((u >> 16) & 1u)) >> 16; }
__device__ __forceinline__ unsigned pk2(float lo, float hi) { return f2bf(lo) | (f2bf(hi) << 16); }
__device__ __forceinline__ float bf2f(unsigned short b) { return __builtin_bit_cast(float, (unsigned)b << 16); }
__device__ __forceinline__ float wave_sum(float v) {
#pragma unroll
    for (int o = 1; o < 64; o <<= 1) v += __shfl_xor(v, o);
    return v;
}
#define LDS_WAIT() asm volatile("s_waitcnt lgkmcnt(0)" ::: "memory")

__device__ __forceinline__ void transpose_item(const float* W, int K, int N, bf16* WT, int dst_row0, LAS float* scr, int k0, int n0, int lane) {
#pragma unroll 8
    for (int i = 0; i < 32; ++i) { const int kk = 2 * i + (lane >> 5); scr[kk * 33 + (lane & 31)] = W[(size_t)(k0 + kk) * N + n0 + (lane & 31)]; }
    LDS_WAIT(); asm volatile("" ::: "memory");
    const int c = lane & 7;
#pragma unroll
    for (int j = 0; j < 4; ++j) { const int n = (lane >> 3) + 8 * j; const LAS float* s = scr + (8 * c) * 33 + n;
        v4u o; o.x = pk2(s[0 * 33], s[1 * 33]); o.y = pk2(s[2 * 33], s[3 * 33]); o.z = pk2(s[4 * 33], s[5 * 33]); o.w = pk2(s[6 * 33], s[7 * 33]);
        *(v4u*)(WT + (size_t)(dst_row0 + n) * K + k0 + 8 * c) = o; }
    LDS_WAIT(); asm volatile("" ::: "memory");
}

struct Args { const float* in[15]; float* out; unsigned char* ws; };

__device__ __forceinline__ void p0_prologue(const Args& a, LAS unsigned char* lds, int G) {
    int tid_ = threadIdx.x; asm volatile("" : "+v"(tid_));
    const int tid = tid_, lane = tid & 63, wave = tid >> 6;
    LAS float* scr = (LAS float*)(lds + wave * 16384);
    const int gw = blockIdx.x * NWAVES + wave, NGW = G * NWAVES;
    constexpr int I_GU = (D / 64) * (DFF / 32), I_DN = (DFF / 64) * (D / 32), I_IN = (D / 64) * (DIN / 32), I_OUT = (D / 64) * (D / 32), I_PL = 4 * 2 * 4;
    constexpr int PER_L = 4 * I_GU + 2 * I_DN + I_IN + I_OUT + I_PL;
    for (int it = gw; it < DEPTH * PER_L; it += NGW) {
        const int l = it / PER_L; int r = it - l * PER_L;
        unsigned char* wl = a.ws + WS_W + (size_t)l * WL_STRIDE;
        if (r < 4 * I_GU) { const int which = r / I_GU; r -= which * I_GU; const int nblk = DFF / 32, kb = r / nblk, nb = r % nblk, n0 = 32 * nb;
            const float* W = a.in[which == 0 ? 7 : (which == 1 ? 8 : (which == 2 ? 10 : 11))] + (size_t)l * D * DFF;
            bf16* WT = (bf16*)(wl + (which < 2 ? WO_GU1 : WO_GU2));
            const int dst = 256 * (n0 >> 7) + (n0 & 127) + ((which & 1) ? 128 : 0);
            transpose_item(W, D, DFF, WT, dst, scr, 64 * kb, n0, lane); continue; }
        r -= 4 * I_GU;
        if (r < 2 * I_DN) { const int which = r / I_DN; r -= which * I_DN; const int nblk = D / 32, kb = r / nblk, nb = r % nblk;
            const float* W = a.in[which == 0 ? 9 : 12] + (size_t)l * DFF * D;
            transpose_item(W, DFF, D, (bf16*)(wl + (which == 0 ? WO_D1 : WO_D2)), 32 * nb, scr, 64 * kb, 32 * nb, lane); continue; }
        r -= 2 * I_DN;
        if (r < I_IN) { const int nblk = DIN / 32, kb = r / nblk, nb = r % nblk;
            transpose_item(a.in[1] + (size_t)l * D * DIN, D, DIN, (bf16*)(wl + WO_IN), 32 * nb, scr, 64 * kb, 32 * nb, lane); continue; }
        r -= I_IN;
        if (r < I_OUT) { const int nblk = D / 32, kb = r / nblk, nb = r % nblk;
            transpose_item(a.in[6] + (size_t)l * D * D, D, D, (bf16*)(wl + WO_OUT), 32 * nb, scr, 64 * kb, 32 * nb, lane); continue; }
        r -= I_OUT;
        { const int g = r >> 3, q = r & 7, kb = q >> 2, nb = q & 3;
            transpose_item(a.in[2] + ((size_t)l * 4 + g) * 128 * 128, 128, 128, (bf16*)(wl + WO_POOL) + (size_t)g * 128 * 128, 32 * nb, scr, 64 * kb, 32 * nb, lane); }
    }
    { const f32x4* x4 = (const f32x4*)a.in[0]; v4u* o = (v4u*)(a.ws + WS_XB);
      for (size_t i = (size_t)blockIdx.x * NTHR + tid; i < (size_t)M * D / 8; i += (size_t)G * NTHR) { const f32x4 p = x4[2 * i], q = x4[2 * i + 1];
          v4u w; w.x = pk2(p[0], p[1]); w.y = pk2(p[2], p[3]); w.z = pk2(q[0], q[1]); w.w = pk2(q[2], q[3]); o[i] = w;
          ((f32x4*)a.out)[2 * i] = p; ((f32x4*)a.out)[2 * i + 1] = q; } }
    if (blockIdx.x == 1) { float* c = (float*)(a.ws + WS_CTL);
        for (int i = tid; i < 4 * 512; i += NTHR) c[CT_PSC / 4 + i] = a.in[3][i];
        for (int i = tid; i < 4 * 128; i += NTHR) c[CT_GN / 4 + i] = a.in[5][i];
    }
    if (blockIdx.x == 0) { const int c = tid; const float* lp = a.in[4]; float* LB = (float*)(a.ws + WS_CTL);
        const float p0 = lp[c], p1 = lp[512 + c], p2 = lp[1024 + c], p3 = lp[1536 + c];
        const float mx = fmaxf(fmaxf(p0, p1), fmaxf(p2, p3));
        const float e0 = expf(p0 - mx), e1 = expf(p1 - mx), e2 = expf(p2 - mx), e3 = expf(p3 - mx), inv = 1.0f / (e0 + e1 + e2 + e3);
        LB[c] = 0.f; LB[512 + c] = e1 * inv; LB[1024 + c] = (e1 + e2) * inv; LB[1536 + c] = (e1 + e2 + e3) * inv; }
}

__device__ __forceinline__ void ln_phase(const float* Z, const float* g, const float* b, float* X, bf16* XB, int G) {
    int tid_ = threadIdx.x; asm volatile("" : "+v"(tid_));
    const int tid = tid_, lane = tid & 63, wave = tid >> 6;
    const int gw = blockIdx.x * NWAVES + wave, NGW = G * NWAVES;
    f32x4 gv[4], bv[4];
#pragma unroll
    for (int j = 0; j < 4; ++j) { gv[j] = ((const f32x4*)g)[lane + 64 * j]; bv[j] = ((const f32x4*)b)[lane + 64 * j]; }
    for (int m = gw; m < M; m += NGW) {
        const f32x4* zr = (const f32x4*)(Z + (size_t)m * D) + lane;
        f32x4 v[4]; float s = 0.f;
#pragma unroll
        for (int j = 0; j < 4; ++j) { v[j] = zr[64 * j]; s += (v[j][0] + v[j][1]) + (v[j][2] + v[j][3]); }
        const float mean = wave_sum(s) * (1.f / D); float s2 = 0.f;
#pragma unroll
        for (int j = 0; j < 4; ++j) { v[j] = v[j] - mean; s2 += (v[j][0] * v[j][0] + v[j][1] * v[j][1]) + (v[j][2] * v[j][2] + v[j][3] * v[j][3]); }
        const float rstd = 1.0f / sqrtf(wave_sum(s2) * (1.f / D) + LN_EPS);
        f32x4* xo = (f32x4*)(X + (size_t)m * D) + lane; v2u* bo = (v2u*)(XB + (size_t)m * D) + lane;
#pragma unroll
        for (int j = 0; j < 4; ++j) { const f32x4 y = v[j] * rstd * gv[j] + bv[j]; xo[64 * j] = y; v2u w; w.x = pk2(y[0], y[1]); w.y = pk2(y[2], y[3]); bo[64 * j] = w; }
    }
}

__device__ __forceinline__ void pool_phase(const bf16* U, const bf16* WP  , const float* pscale  , bf16* YMIX, LAS unsigned char* lds, int G) {
    int tid_ = threadIdx.x; asm volatile("" : "+v"(tid_));
    const int tid = tid_, lane = tid & 63, wave = tid >> 6, fr = lane & 15, fq = lane >> 4;
    LAS bf16* Us = (LAS bf16*)lds;
    LAS bf16* As = (LAS bf16*)(lds + 36864);
    LAS bf16* Bs = (LAS bf16*)(lds + 36864 + 34816);
    for (int un = blockIdx.x; un < 512; un += G) {
        const int tile = un >> 2, g = un & 3, m0 = tile * 128, pos0 = m0 & (SEQ - 1), w = 2 << g;
        for (int i = tid; i < 144 * 16; i += NTHR) { const int r = i >> 4, c16 = i & 15; v4u val = {0u, 0u, 0u, 0u};
            if (!(pos0 == 0 && r < 16)) val = *(const v4u*)(U + (size_t)(m0 - 16 + r) * 512 + g * 128 + c16 * 8);
            *(LAS v4u*)(Us + r * 128 + c16 * 8) = val; }
        for (int i = tid; i < 128 * 16; i += NTHR) { const int r = i >> 4, c16 = i & 15;
            *(LAS v4u*)(Bs + r * 136 + c16 * 8) = *(const v4u*)(WP + (size_t)g * 128 * 128 + r * 128 + c16 * 8); }
        __syncthreads();
        { const int c = tid & 127, r0 = (tid >> 7) * 32; float s = 0.f;
          for (int j = 1; j < w; ++j) s += bf2f(Us[(16 + r0 - j) * 128 + c]);
          for (int r = r0; r < r0 + 32; ++r) { const float cur = bf2f(Us[(16 + r) * 128 + c]); s += cur;
              const int pos = pos0 + r; const float cnt = (float)(pos + 1 < w ? pos + 1 : w);
              As[r * 136 + c] = (bf16)f2bf(s / cnt - cur);
              s -= bf2f(Us[(16 + r - (w - 1)) * 128 + c]); } }
        __syncthreads();
        { bf16x8 af[4]; f32x4 acc[8];
#pragma unroll
          for (int k = 0; k < 4; ++k) af[k] = *(const LAS bf16x8*)(As + (16 * wave + fr) * 136 + k * 32 + fq * 8);
#pragma unroll
          for (int nt = 0; nt < 8; ++nt) { acc[nt] = (f32x4){0.f, 0.f, 0.f, 0.f};
#pragma unroll
              for (int k = 0; k < 4; ++k) { const bf16x8 bfr = *(const LAS bf16x8*)(Bs + (nt * 16 + fr) * 136 + k * 32 + fq * 8);
                  acc[nt] = __builtin_amdgcn_mfma_f32_16x16x32_bf16(bfr, af[k], acc[nt], 0, 0, 0); } }
          const int row = m0 + 16 * wave + fr;
#pragma unroll
          for (int nt = 0; nt < 8; ++nt) { const int d = nt * 16 + fq * 4; const f32x4 ps = *(const f32x4*)(pscale + g * 128 + d); const f32x4 y = acc[nt] * ps;
              v2u o; o.x = pk2(y[0], y[1]); o.y = pk2(y[2], y[3]); *(v2u*)(YMIX + (size_t)row * D + g * 128 + d) = o; } }
        __syncthreads();
    }
}

__device__ __forceinline__ void hgrn_kv_phase(const bf16* V, const float* LOGF, float* KVT, float* DEC, LAS unsigned char* lds, int G) {
    int tid_ = threadIdx.x; asm volatile("" : "+v"(tid_));
    const int tid = tid_, lane = tid & 63, wave = __builtin_amdgcn_readfirstlane(tid >> 6), fr = lane & 15, fq = lane >> 4;
    LAS float* TOT = (LAS float*)lds;
    LAS bf16* VT = (LAS bf16*)(lds + 2048);
    LAS bf16* KDT = (LAS bf16*)(lds + 2048 + 18432);
    const int d = tid & 127, part = tid >> 7;
    for (int uid = blockIdx.x; uid < 1024; uid += G) {
        const int b = uid >> 8, h = (uid >> 6) & 3, n = uid & 63, m0 = b * SEQ + n * CHUNK;
#pragma unroll
        for (int i = 0; i < 2; ++i) { const int c = tid + i * NTHR, s = c >> 4, v0 = (c & 15) * 8;
            const v4u val = *(const v4u*)(V + (size_t)(m0 + s) * 512 + h * 128 + v0);
            const unsigned wv[4] = {val.x, val.y, val.z, val.w};
#pragma unroll
            for (int j = 0; j < 4; ++j) { VT[(v0 + 2 * j) * 72 + s] = (bf16)(wv[j] & 0xffff); VT[(v0 + 2 * j + 1) * 72 + s] = (bf16)(wv[j] >> 16); } }
        float lf[16]; float c = 0.f;
#pragma unroll
        for (int i = 0; i < 16; ++i) { lf[i] = LOGF[(size_t)(m0 + part * 16 + i) * 512 + h * 128 + d]; c += lf[i]; }
        TOT[part * 128 + d] = c;
        __syncthreads();
        { const float t0 = TOT[d], t1 = TOT[128 + d], t2 = TOT[256 + d], t3 = TOT[384 + d];
          const float off = part == 0 ? 0.f : (part == 1 ? t0 : (part == 2 ? t0 + t1 : t0 + t1 + t2)), bL = (t0 + t1) + (t2 + t3);
          float cb = off;
#pragma unroll
          for (int i = 0; i < 16; ++i) { cb += lf[i]; const float kd = (1.0f - __expf(lf[i])) * __expf(bL - cb); KDT[d * 72 + part * 16 + i] = (bf16)f2bf(kd); }
          if (part == 0) DEC[(size_t)uid * 128 + d] = __expf(bL); }
        __syncthreads();
        { bf16x8 af[2]; f32x4 acc[8];
#pragma unroll
          for (int ks = 0; ks < 2; ++ks) af[ks] = *(const LAS bf16x8*)(KDT + (16 * wave + fr) * 72 + ks * 32 + fq * 8);
#pragma unroll
          for (int j = 0; j < 8; ++j) { acc[j] = (f32x4){0.f, 0.f, 0.f, 0.f};
#pragma unroll
              for (int ks = 0; ks < 2; ++ks) { const bf16x8 bfr = *(const LAS bf16x8*)(VT + (16 * j + fr) * 72 + ks * 32 + fq * 8);
                  acc[j] = __builtin_amdgcn_mfma_f32_16x16x32_bf16(af[ks], bfr, acc[j], 0, 0, 0); } }
          float* out = KVT + (size_t)uid * 16384;
#pragma unroll
          for (int j = 0; j < 8; ++j) *(f32x4*)(out + (16 * j + fr) * 128 + 16 * wave + 4 * fq) = acc[j]; }
        __syncthreads();
    }
}
__device__ __forceinline__ void hgrn_scan_phase(float* KVT, const float* DEC, int G) {
    int tid_ = threadIdx.x; asm volatile("" : "+v"(tid_));
    typedef float f32x2 __attribute__((ext_vector_type(2)));
    for (int e = blockIdx.x * NTHR + tid_; e < 16 * 8192; e += G * NTHR) {
        const int bh = e >> 13, i2 = e & 8191, d = (2 * i2) & 127;
        f32x2* p = (f32x2*)(KVT + (size_t)bh * 64 * 16384) + i2; const f32x2* dc = (const f32x2*)(DEC + (size_t)bh * 64 * 128 + d);
        f32x2 S = {0.f, 0.f};
#pragma unroll 8
        for (int n = 0; n < 64; ++n) { const f32x2 kv = p[(size_t)n * 8192], dv = dc[n * 64]; p[(size_t)n * 8192] = S; S = dv * S + kv; }
    }
}
__device__ __forceinline__ void hgrn_out_phase(const bf16* Q, const bf16* V, const bf16* SG, const float* LOGF, const float* ST, const float* gn, bf16* YMIX, LAS unsigned char* lds, int G) {
    int tid_ = threadIdx.x; asm volatile("" : "+v"(tid_));
    const int tid = tid_, lane = tid & 63, wave = __builtin_amdgcn_readfirstlane(tid >> 6), fr = lane & 15, fq = lane >> 4;
    LAS float* TOT = (LAS float*)lds;
    LAS float* RS = (LAS float*)(lds + 2048);
    LAS bf16* VT = (LAS bf16*)(lds + 4096);
    LAS bf16* QI = (LAS bf16*)(lds + 4096 + 18432);
    LAS bf16* QS = QI + 64 * 136;
    LAS bf16* KS = QS + 64 * 136;
    LAS bf16* P = KS + 64 * 136;
    const int d = tid & 127, part = tid >> 7;
    for (int uid = blockIdx.x; uid < 1024; uid += G) {
        const int b = uid >> 8, h = (uid >> 6) & 3, n = uid & 63, m0 = b * SEQ + n * CHUNK;
#pragma unroll
        for (int i = 0; i < 2; ++i) { const int c = tid + i * NTHR, s = c >> 4, v0 = (c & 15) * 8;
            const v4u val = *(const v4u*)(V + (size_t)(m0 + s) * 512 + h * 128 + v0);
            const unsigned wv[4] = {val.x, val.y, val.z, val.w};
#pragma unroll
            for (int j = 0; j < 4; ++j) { VT[(v0 + 2 * j) * 72 + s] = (bf16)(wv[j] & 0xffff); VT[(v0 + 2 * j + 1) * 72 + s] = (bf16)(wv[j] >> 16); } }
        float lf[16]; float c = 0.f;
#pragma unroll
        for (int i = 0; i < 16; ++i) { lf[i] = LOGF[(size_t)(m0 + part * 16 + i) * 512 + h * 128 + d]; c += lf[i]; }
        TOT[part * 128 + d] = c;
        __syncthreads();
        { const float t0 = TOT[d], t1 = TOT[128 + d], t2 = TOT[256 + d];
          const float off = part == 0 ? 0.f : (part == 1 ? t0 : (part == 2 ? t0 + t1 : t0 + t1 + t2)), rr = t0 + t1;
          float cb = off;
#pragma unroll
          for (int i = 0; i < 16; ++i) { cb += lf[i]; const int t = part * 16 + i;
              const float q = bf2f(Q[(size_t)(m0 + t) * 512 + h * 128 + d]), k = 1.0f - __expf(lf[i]);
              QI[t * 136 + d] = (bf16)f2bf(q * __expf(cb));
              QS[t * 136 + d] = (bf16)f2bf(q * __expf(fminf(cb - rr, 80.f)));
              KS[t * 136 + d] = (bf16)f2bf(k * __expf(fminf(rr - cb, 80.f))); } }
        __syncthreads();
        { const int tb = wave >> 1;
#pragma unroll
          for (int u = 0; u < 2; ++u) { const int sb = 2 * (wave & 1) + u; f32x4 acc = {0.f, 0.f, 0.f, 0.f};
              if (sb <= tb) {
#pragma unroll
                  for (int ks = 0; ks < 4; ++ks) { const bf16x8 af = *(const LAS bf16x8*)(KS + (16 * sb + fr) * 136 + ks * 32 + fq * 8), bfr = *(const LAS bf16x8*)(QS + (16 * tb + fr) * 136 + ks * 32 + fq * 8);
                      acc = __builtin_amdgcn_mfma_f32_16x16x32_bf16(af, bfr, acc, 0, 0, 0); }
                  if (sb == tb) {
#pragma unroll
                      for (int r = 0; r < 4; ++r) if (4 * fq + r > fr) acc[r] = 0.f; } }
              v2u o; o.x = pk2(acc[0], acc[1]); o.y = pk2(acc[2], acc[3]);
              *(LAS v2u*)(P + (16 * tb + fr) * 72 + 16 * sb + 4 * fq) = o; } }
        __syncthreads();
        f32x4 acc[4];
        { const float* st = ST + (size_t)uid * 16384 + (size_t)(16 * wave + fr) * 128 + fq * 8;
          bf16x8 sf[4];
#pragma unroll
          for (int ks = 0; ks < 4; ++ks) { const f32x4 a0 = *(const f32x4*)(st + ks * 32), a1 = *(const f32x4*)(st + ks * 32 + 4);
              v4u w; w.x = pk2(a0[0], a0[1]); w.y = pk2(a0[2], a0[3]); w.z = pk2(a1[0], a1[1]); w.w = pk2(a1[2], a1[3]); sf[ks] = __builtin_bit_cast(bf16x8, w); }
          bf16x8 vf[2];
#pragma unroll
          for (int ks = 0; ks < 2; ++ks) vf[ks] = *(const LAS bf16x8*)(VT + (16 * wave + fr) * 72 + ks * 32 + fq * 8);
#pragma unroll
          for (int tb = 0; tb < 4; ++tb) { acc[tb] = (f32x4){0.f, 0.f, 0.f, 0.f};
#pragma unroll
              for (int ks = 0; ks < 4; ++ks) { const bf16x8 bfr = *(const LAS bf16x8*)(QI + (16 * tb + fr) * 136 + ks * 32 + fq * 8);
                  acc[tb] = __builtin_amdgcn_mfma_f32_16x16x32_bf16(sf[ks], bfr, acc[tb], 0, 0, 0); }
#pragma unroll
              for (int ks = 0; ks < 2; ++ks) { if (ks == 1 && tb < 2) continue;
                  const bf16x8 bfr = *(const LAS bf16x8*)(P + (16 * tb + fr) * 72 + ks * 32 + fq * 8);
                  acc[tb] = __builtin_amdgcn_mfma_f32_16x16x32_bf16(vf[ks], bfr, acc[tb], 0, 0, 0); } }
#pragma unroll
          for (int tb = 0; tb < 4; ++tb) { float ss = (acc[tb][0] * acc[tb][0] + acc[tb][1] * acc[tb][1]) + (acc[tb][2] * acc[tb][2] + acc[tb][3] * acc[tb][3]);
              ss += __shfl_xor(ss, 16); ss += __shfl_xor(ss, 32);
              if (fq == 0) RS[(16 * tb + fr) * 8 + wave] = ss; } }
        __syncthreads();
        { const int v0 = 16 * wave + 4 * fq; const f32x4 gv = *(const f32x4*)(gn + v0);
#pragma unroll
          for (int tb = 0; tb < 4; ++tb) { const int t = 16 * tb + fr; const LAS f32x4* rs = (const LAS f32x4*)(RS + t * 8); const f32x4 r0 = rs[0], r1 = rs[1];
              const float ss = ((r0[0] + r0[1]) + (r0[2] + r0[3])) + ((r1[0] + r1[1]) + (r1[2] + r1[3]));
              const float rstd = 1.0f / sqrtf(ss * (1.0f / 128.0f) + RMS_EPS);
              const v2u sg = *(const v2u*)(SG + (size_t)(m0 + t) * 512 + h * 128 + v0);
              const float y0 = acc[tb][0] * rstd * gv[0] * bf2f((unsigned short)(sg.x & 0xffff)), y1 = acc[tb][1] * rstd * gv[1] * bf2f((unsigned short)(sg.x >> 16)),
                          y2 = acc[tb][2] * rstd * gv[2] * bf2f((unsigned short)(sg.y & 0xffff)), y3 = acc[tb][3] * rstd * gv[3] * bf2f((unsigned short)(sg.y >> 16));
              v2u o; o.x = pk2(y0, y1); o.y = pk2(y2, y3);
              *(v2u*)(YMIX + (size_t)(m0 + t) * D + 512 + h * 128 + v0) = o; } }
        __syncthreads();
    }
}

__global__ void __launch_bounds__(NTHR, 2) trunk_fwd(Args a) {
    extern __shared__ __attribute__((aligned(16))) unsigned char lds_raw[];
    LAS unsigned char* lds = (LAS unsigned char*)lds_raw;
    cg::grid_group grid = cg::this_grid();
    const int G = gridDim.x;
    p0_prologue(a, lds, G);
    grid.sync();
#define PTRS() unsigned wl_ = __builtin_amdgcn_readfirstlane((unsigned)(size_t)a.ws), wh_ = __builtin_amdgcn_readfirstlane((unsigned)((size_t)a.ws >> 32)), \
             xl_ = __builtin_amdgcn_readfirstlane((unsigned)(size_t)a.out), xh_ = __builtin_amdgcn_readfirstlane((unsigned)((size_t)a.out >> 32)); \
    asm volatile("" : "+s"(wl_), "+s"(wh_), "+s"(xl_), "+s"(xh_)); \
    unsigned char* ws = (unsigned char*)(((size_t)wh_ << 32) | wl_); float* X = (float*)(((size_t)xh_ << 32) | xl_); \
    bf16* XB = (bf16*)(ws + WS_XB); bf16* H = (bf16*)(ws + WS_R1); \
    bf16* U = (bf16*)(ws + WS_R1); bf16* Q = U + (size_t)M * 512; bf16* V = Q + (size_t)M * 512; bf16* SG = V + (size_t)M * 512; float* LOGF = (float*)(SG + (size_t)M * 512); \
    float* Z = (float*)(ws + WS_R2); float* KVT = (float*)(ws + WS_R2); float* DEC = (float*)(ws + WS_DEC); bf16* YMIX = (bf16*)(ws + WS_YMIX); \
    const float* CT = (const float*)(ws + WS_CTL); const unsigned char* wl = ws + WS_W + (size_t)l * WL_STRIDE; \
    (void)XB; (void)H; (void)U; (void)Q; (void)V; (void)SG; (void)LOGF; (void)Z; (void)KVT; (void)DEC; (void)YMIX; (void)CT; (void)wl; (void)X
#pragma nounroll
    for (int l = 0; l < DEPTH; ++l) {
#pragma nounroll
        for (int half = 0; half < 2; ++half) {
            if (half == 1) {
#ifndef SKIP_IN
                { PTRS(); pg8::Gemm g{XB, (const bf16*)(wl + WO_IN), M, DIN, D}; pg8::StaticOrder S; S.init(M, DIN, G, (int)blockIdx.x);
                  pg8::EpiIn E{U, Q, V, SG, LOGF, CT + CT_LB / 4 + l * 512};
                  pg8::gemm_phase<pg8::EpiIn, pg8::StaticOrder, true, true>(lds, g, S, E); }
#endif
                grid.sync();
#ifndef SKIP_POOL
                { PTRS(); pool_phase(U, (const bf16*)(wl + WO_POOL), CT + CT_PSC / 4 + l * 512, YMIX, lds, G); }
#endif
#ifndef SKIP_SEQ
                { PTRS(); hgrn_kv_phase(V, LOGF, KVT, DEC, lds, G); }
                grid.sync();
                { PTRS(); hgrn_scan_phase(KVT, DEC, G); }
                grid.sync();
                { PTRS(); hgrn_out_phase(Q, V, SG, LOGF, KVT, CT + CT_GN / 4 + l * 128, YMIX, lds, G); }
#endif
                grid.sync();
#ifndef SKIP_OUT
                { PTRS(); pg8::Gemm g{YMIX, (const bf16*)(wl + WO_OUT), M, D, D}; pg8::StaticOrder S; S.init(M, D, G, (int)blockIdx.x);
                  pg8::EpiResid E{X, Z, D, ALPHA, 1.0f};
                  pg8::gemm_phase<pg8::EpiResid, pg8::StaticOrder, true, true>(lds, g, S, E); }
#endif
                grid.sync();
                { PTRS(); ln_phase(Z, a.in[13] + (l * 3 + 1) * D, a.in[14] + (l * 3 + 1) * D, X, XB, G); }
                grid.sync();
            }
#ifndef SKIP_GU
            { PTRS(); pg8::Gemm g{XB, (const bf16*)(wl + (half == 0 ? WO_GU1 : WO_GU2)), M, 2 * DFF, D}; pg8::StaticOrder S; S.init(M, 2 * DFF, G, (int)blockIdx.x);
              pg8::EpiSwiglu E{H, DFF};
              pg8::gemm_phase<pg8::EpiSwiglu, pg8::StaticOrder, true, true>(lds, g, S, E); }
#endif
            grid.sync();
#ifndef SKIP_DN
            { PTRS(); pg8::Gemm g{H, (const bf16*)(wl + (half == 0 ? WO_D1 : WO_D2)), M, D, DFF}; pg8::StaticOrder S; S.init(M, D, G, (int)blockIdx.x);
              pg8::EpiResid E{X, Z, D, ALPHA, 0.5f};
              pg8::gemm_phase<pg8::EpiResid, pg8::StaticOrder, true, true>(lds, g, S, E); }
#endif
            grid.sync();
            { PTRS(); const int li = l * 3 + (half == 0 ? 0 : 2); ln_phase(Z, a.in[13] + li * D, a.in[14] + li * D, X, XB, G); }
            grid.sync();
        }
    }
}

extern "C" void kernel_launch(void* const* d_in, const int* in_sizes, int n_in, void* d_out, int out_size, void* d_ws, size_t ws_size, hipStream_t stream) {
    static int grid = 0;
    if (grid == 0) {
        if (n_in != 15 || in_sizes[0] != M * D || out_size != M * D || ws_size < WS_END) { fprintf(stderr, "kernel_launch: shape/workspace mismatch (n_in %d, in0 %d, out %d, ws %zu, need %zu)\n", n_in, n_in > 0 ? in_sizes[0] : -1, out_size, ws_size, (size_t)WS_END); grid = -1; return; }
        int dev = 0, cus = 0, per_cu = 0;
        hipGetDevice(&dev); hipDeviceGetAttribute(&cus, hipDeviceAttributeMultiprocessorCount, dev);
        if (hipFuncSetAttribute((const void*)trunk_fwd, hipFuncAttributeMaxDynamicSharedMemorySize, LDS_BYTES) != hipSuccess) { fprintf(stderr, "kernel_launch: hipFuncSetAttribute failed\n"); grid = -1; return; }
        if (hipOccupancyMaxActiveBlocksPerMultiprocessor(&per_cu, (const void*)trunk_fwd, NTHR, LDS_BYTES) != hipSuccess || per_cu < 1) { fprintf(stderr, "kernel_launch: occupancy query says %d\n", per_cu); per_cu = 1; }
        (void)hipGetLastError();
        grid = cus * 1;
    }
    if (grid < 0) return;
    Args a{};
    for (int i = 0; i < 15; ++i) a.in[i] = (const float*)d_in[i];
    a.out = (float*)d_out; a.ws = (unsigned char*)d_ws;
    void* kargs[] = {&a};
    hipError_t e = hipLaunchCooperativeKernel((const void*)trunk_fwd, dim3(grid), dim3(NTHR), kargs, LDS_BYTES, stream);
    if (e != hipSuccess) fprintf(stderr, "kernel_launch: cooperative launch failed: %s (grid %d)\n", hipGetErrorString(e), grid);
}
```
